# Optimizing an MI355X kernel written in HIP

```python
import jax, jax.numpy as jnp
from jax import lax
import numpy as np

D_MODEL = 1024
BATCH = 4
SEQ = 8192
DEPTH = 2

D_MIX = D_MODEL
GROUP_W = D_MIX // 4
ROPE_THETA = 500000.0
NORM_EPS = 1e-6
Q_BLOCK = 128
NEG = -1e30
FORCE = 1e4
F32 = jnp.float32

MLA_HEADS = 4
MLA_NOPE = 64
MLA_ROPE = 32
MLA_V = GROUP_W // MLA_HEADS
MLA_Q_RANK = 192
MLA_KV_RANK = 128

NSA_HEADS = 4
NSA_HD = GROUP_W // NSA_HEADS
NSA_ROT = NSA_HD // 4
CMP_STRIDE = 16
CMP_LEN = 2 * CMP_STRIDE
SEL_LEN = 64
SEL_TOPN = 16
WINDOW = 512

LRU_W = GROUP_W
LRU_BLOCKS = 4
LRU_BW = LRU_W // LRU_BLOCKS
LRU_C = 8.0
CONV_W = 4

SSD_HEADS = 4
SSD_HD = GROUP_W // SSD_HEADS
SSD_GROUPS = 2
SSD_STATE = 128
SSD_CHUNK = 128
SSD_DI = SSD_HEADS * SSD_HD
SSD_XBC = SSD_DI + 2 * SSD_GROUPS * SSD_STATE

MLA_COLS = MLA_Q_RANK + MLA_KV_RANK + MLA_ROPE
NSA_COLS = NSA_HEADS * NSA_HD + 6 * NSA_HD + 3 * NSA_HEADS
LRU_COLS = 2 * LRU_W
SSD_COLS = SSD_DI + SSD_XBC + SSD_HEADS
IN_COLS = MLA_COLS + NSA_COLS + LRU_COLS + SSD_COLS

D_FF = 3584
N_EXPERTS = 8
TOP_K = 2
N_DENSE = (DEPTH + 1) // 2
N_MOE = DEPTH // 2

kernel_name = 'hybrid_mla_nsa_rglru_ssd_moe'


def rms_norm(x, g):
    xf = x.astype(F32)
    y = xf * lax.rsqrt(jnp.mean(xf * xf, axis=-1, keepdims=True) + NORM_EPS)
    return (y * g.astype(F32)).astype(x.dtype)


def rope_tables(positions, rot_dim):
    inv = ROPE_THETA ** (-jnp.arange(0, rot_dim, 2, dtype=F32) / rot_dim)
    ang = positions.astype(F32)[:, None] * inv[None, :]
    return jnp.cos(ang), jnp.sin(ang)


def apply_rope(x, cos, sin, rot_dim):
    half = rot_dim // 2
    xf = x.astype(F32)
    x1, x2, xp = xf[..., :half], xf[..., half:rot_dim], xf[..., rot_dim:]
    c, s = cos[None, :, None, :], sin[None, :, None, :]
    return jnp.concatenate([x1 * c - x2 * s, x2 * c + x1 * s, xp], axis=-1).astype(x.dtype)


def causal_dwconv(x, w, b):
    K, C = w.shape
    y = lax.conv_general_dilated(x, w[:, None, :].astype(x.dtype), window_strides=(1,),
                                 padding=[(K - 1, 0)], dimension_numbers=('NWC', 'WIO', 'NWC'),
                                 feature_group_count=C)
    return y + b.astype(x.dtype)


def swiglu(h, wg, wu, wd):
    return (jax.nn.silu(h @ wg) * (h @ wu)) @ wd


def causal_attention_blocks(q, k, v, scale):
    B, S, H, Dk = q.shape
    nb = S // Q_BLOCK
    qb = q.reshape(B, nb, Q_BLOCK, H, Dk).transpose(1, 0, 2, 3, 4)
    kf, vf = k.astype(F32), v.astype(F32)
    kpos = jnp.arange(S)

    def one(args):
        i, qi = args
        s = jnp.einsum('bqhd,bkhd->bhqk', qi.astype(F32), kf) * scale
        qpos = i * Q_BLOCK + jnp.arange(Q_BLOCK)
        s = jnp.where(kpos[None, :] <= qpos[:, None], s, NEG)
        p = jax.nn.softmax(s, axis=-1)
        return jnp.einsum('bhqk,bkhd->bqhd', p, vf)

    o = lax.map(one, (jnp.arange(nb), qb))
    return o.transpose(1, 0, 2, 3, 4).reshape(B, S, H, v.shape[-1])


def mla_mixer(u, cos, sin, q_norm, w_uq, kv_norm, w_ukv):
    B, S, _ = u.shape
    c_q = u[..., :MLA_Q_RANK]
    c_kv = u[..., MLA_Q_RANK:MLA_Q_RANK + MLA_KV_RANK]
    k_pe = u[..., MLA_Q_RANK + MLA_KV_RANK:][:, :, None, :]
    q = (rms_norm(c_q, q_norm) @ w_uq).reshape(B, S, MLA_HEADS, MLA_NOPE + MLA_ROPE)
    kv = (rms_norm(c_kv, kv_norm) @ w_ukv).reshape(B, S, MLA_HEADS, MLA_NOPE + MLA_V)
    q = jnp.concatenate([q[..., :MLA_NOPE], apply_rope(q[..., MLA_NOPE:], cos, sin, MLA_ROPE)], axis=-1)
    k_pe = jnp.broadcast_to(apply_rope(k_pe, cos, sin, MLA_ROPE), (B, S, MLA_HEADS, MLA_ROPE))
    k = jnp.concatenate([kv[..., :MLA_NOPE], k_pe.astype(kv.dtype)], axis=-1)
    v = kv[..., MLA_NOPE:]
    o = causal_attention_blocks(q, k, v, (MLA_NOPE + MLA_ROPE) ** -0.5)
    return o.reshape(B, S, MLA_HEADS * MLA_V)


def nsa_mixer(u, cos, sin, cmp_pe, w_cmp):
    B, S, _ = u.shape
    H, d = NSA_HEADS, NSA_HD
    q = apply_rope(u[..., :H * d].reshape(B, S, H, d), cos, sin, NSA_ROT)
    kvs = u[..., H * d:H * d + 6 * d].reshape(B, S, 6, d)
    gates = jax.nn.sigmoid(u[..., H * d + 6 * d:].astype(F32)).reshape(B, S, H, 3)
    keys = apply_rope(kvs[:, :, 0::2], cos, sin, NSA_ROT)
    vals = kvs[:, :, 1::2]
    scale = d ** -0.5

    nc = S // CMP_STRIDE - 1

    def compress(t, pe, w):
        ch = t.reshape(B, S // CMP_STRIDE, CMP_STRIDE, d)
        blk = jnp.concatenate([ch[:, :-1], ch[:, 1:]], axis=2)
        return ((blk + pe).reshape(B, nc, CMP_LEN * d) @ w).astype(F32)

    kc = compress(keys[:, :, 0], cmp_pe[0], w_cmp[0])
    vc = compress(vals[:, :, 0], cmp_pe[1], w_cmp[1])
    cmp_start = jnp.arange(nc) * CMP_STRIDE
    cmp_last = cmp_start + CMP_LEN - 1

    n_sel = S // SEL_LEN
    n_top = min(SEL_TOPN, n_sel)
    ks_blk = keys[:, :, 1].astype(F32).reshape(B, n_sel, SEL_LEN, d)
    vs_blk = vals[:, :, 1].astype(F32).reshape(B, n_sel, SEL_LEN, d)
    sel_start = jnp.arange(n_sel) * SEL_LEN
    overlap = ((cmp_start[:, None] <= sel_start[None, :] + SEL_LEN - 1)
               & (cmp_last[:, None] >= sel_start[None, :])).astype(F32)

    kw_pad = jnp.pad(keys[:, :, 2].astype(F32), ((0, 0), (WINDOW, 0), (0, 0)))
    vw_pad = jnp.pad(vals[:, :, 2].astype(F32), ((0, 0), (WINDOW, 0), (0, 0)))

    nb = S // Q_BLOCK
    qb = q.reshape(B, nb, Q_BLOCK, H, d).transpose(1, 0, 2, 3, 4)
    gb = gates.reshape(B, nb, Q_BLOCK, H, 3).transpose(1, 0, 2, 3, 4)
    jj = jnp.arange(n_sel)
    woff = jnp.arange(WINDOW + Q_BLOCK)

    def one(args):
        i, qi, gi = args
        qf = qi.astype(F32)
        qpos = i * Q_BLOCK + jnp.arange(Q_BLOCK)
        m_c = cmp_last[None, :] <= qpos[:, None]
        s_c = jnp.einsum('bqhd,bnd->bhqn', qf, kc) * scale
        p_c = jax.nn.softmax(jnp.where(m_c, s_c, NEG), axis=-1) * m_c
        o_c = jnp.einsum('bhqn,bnd->bqhd', p_c, vc)
        imp = jnp.einsum('bhqn,nj->bqj', p_c, overlap)
        cur = qpos // SEL_LEN
        forced = (jj[None, :] == 0) | (jj[None, :] == cur[:, None]) | (jj[None, :] == cur[:, None] - 1)
        imp = jnp.where(jj[None, :] <= cur[:, None], imp + FORCE * forced, NEG)
        top_v, idx = lax.top_k(imp, n_top)
        ok = top_v > 0.5 * NEG
        ksg = jax.vmap(lambda kb, ix: kb[ix])(ks_blk, idx)
        vsg = jax.vmap(lambda vb, ix: vb[ix])(vs_blk, idx)
        tok = idx[..., None] * SEL_LEN + jnp.arange(SEL_LEN)
        m_s = (tok <= qpos[None, :, None, None]) & ok[..., None]
        s_s = jnp.einsum('bqhd,bqnkd->bhqnk', qf, ksg) * scale
        s_s = jnp.where(m_s[:, None], s_s, NEG)
        p_s = jax.nn.softmax(s_s.reshape(B, H, Q_BLOCK, -1), axis=-1).reshape(s_s.shape)
        o_s = jnp.einsum('bhqnk,bqnkd->bqhd', p_s, vsg)
        kwi = lax.dynamic_slice_in_dim(kw_pad, i * Q_BLOCK, WINDOW + Q_BLOCK, axis=1)
        vwi = lax.dynamic_slice_in_dim(vw_pad, i * Q_BLOCK, WINDOW + Q_BLOCK, axis=1)
        kpos = i * Q_BLOCK - WINDOW + woff
        m_w = ((kpos[None, :] <= qpos[:, None]) & (kpos[None, :] > qpos[:, None] - WINDOW)
               & (kpos[None, :] >= 0))
        s_w = jnp.einsum('bqhd,bkd->bhqk', qf, kwi) * scale
        p_w = jax.nn.softmax(jnp.where(m_w, s_w, NEG), axis=-1)
        o_w = jnp.einsum('bhqk,bkd->bqhd', p_w, vwi)
        return gi[..., 0:1] * o_c + gi[..., 1:2] * o_s + gi[..., 2:3] * o_w

    o = lax.map(one, (jnp.arange(nb), qb, gb))
    return o.transpose(1, 0, 2, 3, 4).reshape(B, S, H * d)


def rglru_mixer(u, conv_w, conv_b, w_gate, b_gate, lam):
    B, S, _ = u.shape
    xb = causal_dwconv(u[..., :LRU_W], conv_w, conv_b).astype(F32)
    gbr = u[..., LRU_W:].astype(F32)
    xblk = xb.reshape(B, S, LRU_BLOCKS, LRU_BW)
    g = jnp.einsum('bsnc,gncd->gbsnd', xblk, w_gate.astype(F32)).reshape(2, B, S, LRU_W)
    g = g + b_gate.astype(F32)[:, None, None, :]
    r, i_g = jax.nn.sigmoid(g[0]), jax.nn.sigmoid(g[1])
    log_a = -LRU_C * r * jax.nn.softplus(-lam.astype(F32))
    a = jnp.exp(log_a)
    b = jnp.sqrt(jnp.maximum(-jnp.expm1(2.0 * log_a), 0.0)) * (i_g * xb)

    def comb(e1, e2):
        a1, b1 = e1
        a2, b2 = e2
        return a1 * a2, a2 * b1 + b2

    _, h = lax.associative_scan(comb, (a, b), axis=1)
    return h * jax.nn.gelu(gbr)


def segsum(x):
    T = x.shape[-1]
    xx = jnp.broadcast_to(x[..., None], x.shape + (T,))
    xx = jnp.where(jnp.tril(jnp.ones((T, T), bool), -1), xx, 0.0)
    cs = jnp.cumsum(xx, axis=-2)
    return jnp.where(jnp.tril(jnp.ones((T, T), bool), 0), cs, -jnp.inf)


def ssd_chunked(xdt, dA, Bm, Cm):
    B, S, H, P = xdt.shape
    N = Bm.shape[-1]
    L = SSD_CHUNK
    c = S // L
    x = xdt.reshape(B, c, L, H, P)
    Bc = Bm.reshape(B, c, L, H, N)
    Cc = Cm.reshape(B, c, L, H, N)
    a = dA.reshape(B, c, L, H).transpose(0, 3, 1, 2)
    a_cs = jnp.cumsum(a, axis=-1)
    Lm = jnp.exp(segsum(a))
    scores = jnp.einsum('bclhn,bcshn->bhcls', Cc, Bc) * Lm
    y_diag = jnp.einsum('bhcls,bcshp->bclhp', scores, x)
    decay_states = jnp.exp(a_cs[..., -1:] - a_cs)
    states = jnp.einsum('bclhn,bhcl,bclhp->bchpn', Bc, decay_states, x)
    states = jnp.concatenate([jnp.zeros_like(states[:, :1]), states], axis=1)
    decay_chunk = jnp.exp(segsum(jnp.pad(a_cs[..., -1], ((0, 0), (0, 0), (1, 0)))))
    states = jnp.einsum('bhzc,bchpn->bzhpn', decay_chunk, states)[:, :-1]
    y_off = jnp.einsum('bclhn,bchpn,bhcl->bclhp', Cc, states, jnp.exp(a_cs))
    return (y_diag + y_off).reshape(B, S, H, P)


def ssd_mixer(u, conv_w, conv_b, dt_bias, a_log, d_skip, norm_g):
    B, S, _ = u.shape
    z = u[..., :SSD_DI].astype(F32)
    xbc = jax.nn.silu(causal_dwconv(u[..., SSD_DI:SSD_DI + SSD_XBC], conv_w, conv_b).astype(F32))
    dt = u[..., SSD_DI + SSD_XBC:].astype(F32)
    gn = SSD_GROUPS * SSD_STATE
    xs = xbc[..., :SSD_DI].reshape(B, S, SSD_HEADS, SSD_HD)
    rep = SSD_HEADS // SSD_GROUPS
    Bm = jnp.repeat(xbc[..., SSD_DI:SSD_DI + gn].reshape(B, S, SSD_GROUPS, SSD_STATE), rep, axis=2)
    Cm = jnp.repeat(xbc[..., SSD_DI + gn:].reshape(B, S, SSD_GROUPS, SSD_STATE), rep, axis=2)
    dt = jax.nn.softplus(dt + dt_bias.astype(F32))
    A = -jnp.exp(a_log.astype(F32))
    y = ssd_chunked(xs * dt[..., None], dt * A, Bm, Cm)
    y = y + xs * d_skip.astype(F32)[:, None]
    y = y.reshape(B, S, SSD_DI) * jax.nn.silu(z)
    return rms_norm(y, norm_g)


def moe_ffn(h, router, w_gate, w_up, w_down):
    B, S, D = h.shape
    t = h.reshape(B * S, D)
    logits = (t @ router).astype(F32)
    top_v, idx = lax.top_k(logits, TOP_K)
    wts = jax.nn.softmax(top_v, axis=-1)
    gate = jnp.sum(jax.nn.one_hot(idx, N_EXPERTS, dtype=F32) * wts[..., None], axis=1)
    out = jnp.zeros((B * S, D), F32)
    for e in range(N_EXPERTS):
        out = out + gate[:, e:e + 1] * swiglu(t, w_gate[e], w_up[e], w_down[e]).astype(F32)
    return out.reshape(B, S, D)


def setup_inputs(seed: int = 0) -> dict:
    key = jax.random.key(seed)
    ks = iter(jax.random.split(key, 40))
    nrm = lambda shape, scale: jax.random.normal(next(ks), shape, F32) * scale
    gain = lambda shape: 1.0 + 0.02 * jax.random.normal(next(ks), shape, F32)
    L = DEPTH
    u_a = jax.random.uniform(next(ks), (L, LRU_W), F32, 0.9, 0.999)
    s_a = u_a ** (1.0 / LRU_C)
    dt0 = jnp.exp(jax.random.uniform(next(ks), (L, SSD_HEADS), F32, np.log(1e-3), np.log(1e-1)))
    return {
        'x': jax.random.normal(next(ks), (BATCH, SEQ, D_MODEL), F32),
        'positions': jnp.arange(SEQ, dtype=jnp.int32),
        'norm_mix': gain((L, D_MODEL)),
        'w_in': nrm((L, D_MODEL, IN_COLS), D_MODEL ** -0.5),
        'mla_q_norm': gain((L, MLA_Q_RANK)),
        'mla_w_uq': nrm((L, MLA_Q_RANK, MLA_HEADS * (MLA_NOPE + MLA_ROPE)), MLA_Q_RANK ** -0.5),
        'mla_kv_norm': gain((L, MLA_KV_RANK)),
        'mla_w_ukv': nrm((L, MLA_KV_RANK, MLA_HEADS * (MLA_NOPE + MLA_V)), MLA_KV_RANK ** -0.5),
        'nsa_cmp_pe': nrm((L, 2, CMP_LEN, NSA_HD), 0.02),
        'nsa_w_cmp': nrm((L, 2, CMP_LEN * NSA_HD, NSA_HD), (CMP_LEN * NSA_HD) ** -0.5),
        'lru_conv_w': nrm((L, CONV_W, LRU_W), CONV_W ** -0.5),
        'lru_conv_b': nrm((L, LRU_W), 0.01),
        'lru_w_gate': nrm((L, 2, LRU_BLOCKS, LRU_BW, LRU_BW), LRU_BW ** -0.5),
        'lru_b_gate': nrm((L, 2, LRU_W), 0.01),
        'lru_lambda': jnp.log(s_a / (1.0 - s_a)),
        'ssd_conv_w': nrm((L, CONV_W, SSD_XBC), CONV_W ** -0.5),
        'ssd_conv_b': nrm((L, SSD_XBC), 0.01),
        'ssd_dt_bias': dt0 + jnp.log(-jnp.expm1(-dt0)),
        'ssd_a_log': jnp.log(jax.random.uniform(next(ks), (L, SSD_HEADS), F32, 1.0, 16.0)),
        'ssd_d': gain((L, SSD_HEADS)),
        'group_norm': gain((L, 4, GROUP_W)),
        'w_out': nrm((L, D_MIX, D_MODEL), D_MIX ** -0.5),
        'norm_ffn': gain((L, D_MODEL)),
        'ffn_w_gate': nrm((N_DENSE, D_MODEL, D_FF), D_MODEL ** -0.5),
        'ffn_w_up': nrm((N_DENSE, D_MODEL, D_FF), D_MODEL ** -0.5),
        'ffn_w_down': nrm((N_DENSE, D_FF, D_MODEL), D_FF ** -0.5),
        'moe_router': nrm((N_MOE, D_MODEL, N_EXPERTS), D_MODEL ** -0.5),
        'moe_w_gate': nrm((N_MOE, N_EXPERTS, D_MODEL, D_FF), D_MODEL ** -0.5),
        'moe_w_up': nrm((N_MOE, N_EXPERTS, D_MODEL, D_FF), D_MODEL ** -0.5),
        'moe_w_down': nrm((N_MOE, N_EXPERTS, D_FF, D_MODEL), D_FF ** -0.5),
        'norm_final': gain((D_MODEL,)),
    }


def reference(x, positions, norm_mix, w_in, mla_q_norm, mla_w_uq, mla_kv_norm, mla_w_ukv,
              nsa_cmp_pe, nsa_w_cmp, lru_conv_w, lru_conv_b, lru_w_gate, lru_b_gate, lru_lambda,
              ssd_conv_w, ssd_conv_b, ssd_dt_bias, ssd_a_log, ssd_d, group_norm, w_out, norm_ffn,
              ffn_w_gate, ffn_w_up, ffn_w_down, moe_router, moe_w_gate, moe_w_up, moe_w_down,
              norm_final):
    cos_m, sin_m = rope_tables(positions, MLA_ROPE)
    cos_n, sin_n = rope_tables(positions, NSA_ROT)
    o1 = MLA_COLS
    o2 = o1 + NSA_COLS
    o3 = o2 + LRU_COLS
    h_res = x
    for l in range(DEPTH):
        h = rms_norm(h_res, norm_mix[l])
        u = h @ w_in[l]
        y_a = mla_mixer(u[..., :o1], cos_m, sin_m, mla_q_norm[l], mla_w_uq[l], mla_kv_norm[l], mla_w_ukv[l])
        y_b = nsa_mixer(u[..., o1:o2], cos_n, sin_n, nsa_cmp_pe[l], nsa_w_cmp[l])
        y_c = rglru_mixer(u[..., o2:o3], lru_conv_w[l], lru_conv_b[l], lru_w_gate[l], lru_b_gate[l], lru_lambda[l])
        y_d = ssd_mixer(u[..., o3:], ssd_conv_w[l], ssd_conv_b[l], ssd_dt_bias[l], ssd_a_log[l], ssd_d[l],
                        group_norm[l, 3])
        g = group_norm[l]
        y = jnp.concatenate([rms_norm(y_a, g[0]), rms_norm(y_b, g[1]), rms_norm(y_c, g[2]), y_d], axis=-1)
        h_res = h_res + y @ w_out[l]
        h = rms_norm(h_res, norm_ffn[l])
        if l % 2 == 0:
            f = swiglu(h, ffn_w_gate[l // 2], ffn_w_up[l // 2], ffn_w_down[l // 2])
        else:
            f = moe_ffn(h, moe_router[l // 2], moe_w_gate[l // 2], moe_w_up[l // 2], moe_w_down[l // 2])
        h_res = h_res + f
    return rms_norm(h_res, norm_final).astype(x.dtype)
```

```cpp
#include <hip/hip_runtime.h>
#include <cstdio>
#include <cstdint>
#ifndef EPI_REP
#define EPI_REP 1
#endif
namespace pg8 {
#define PG8_LAS __attribute__((address_space(3)))
typedef unsigned short bf16_t;
typedef short bf16x8 __attribute__((ext_vector_type(8)));
typedef float f32x4 __attribute__((ext_vector_type(4)));
typedef unsigned u32x4 __attribute__((ext_vector_type(4)));
typedef int v4i_t __attribute__((ext_vector_type(4)));
typedef int v8i_t __attribute__((ext_vector_type(8)));
constexpr int BM = 256, BK = 64, HALF = 128, HTB = HALF * BK * 2  , STAGE_BYTES = 8 * HTB, NXCD = 8, WGM = 8;

__host__ __device__ __forceinline__ int lds_byte(int r, int c) { const int st = (r >> 4) * 2 + (c >> 5), rr = r & 15, cc = c & 31, ob = rr * 64 + cc * 2; return st * 1024 + (ob ^ (((ob >> 9) & 1) << 5)); }
__host__ __device__ __forceinline__ void stage_rc(int b, int& R, int& C) { const int st = b / 1024, sb = b % 1024, swz = sb ^ (((sb >> 9) & 1) << 5); R = (st >> 1) * 16 + swz / 64; C = (st & 1) * 32 + (swz % 64) / 2; }
__host__ __device__ __forceinline__ int perm32(int rho) { const int n = rho >> 4, i = rho & 15; return 8 * (i >> 2) + 4 * n + (i & 3); }

struct Unit { int pm, pn, ks; };
struct Gemm { const bf16_t* A; const bf16_t* Bt; int M, N, K; int kt_full; };

struct StaticOrder {
    int nM, nN, nwg, G, c;
    __host__ __device__ void init(int M, int N, int G_, int c_) { nM = M / BM; nN = N / BM; nwg = nM * nN; G = G_; c = c_; }
    __host__ __device__ bool next(int i, Unit& u) const {
        const long L = (long)i * G + c; if (L >= nwg) return false;
        int wgid = (int)L; { const int q = nwg / NXCD, r = nwg % NXCD, xcd = wgid % NXCD, off = wgid / NXCD; wgid = (xcd < r ? xcd * (q + 1) : r * (q + 1) + (xcd - r) * q) + off; }
        const int nig = WGM * nN, gid = wgid / nig, fm = gid * WGM, gsz = (nM - fm) < WGM ? (nM - fm) : WGM;
        u.pm = fm + ((wgid % nig) % gsz); u.pn = (wgid % nig) / gsz; u.ks = 0; return true;
    }
    __device__ __forceinline__ void a_ready(const Unit&) const {}
    __device__ __forceinline__ void done(const Unit&) const {}
    __device__ __forceinline__ size_t bofs(const Unit&) const { return 0; }
};

__device__ __forceinline__ unsigned cvt_pk_bf16(float lo, float hi) { unsigned r; asm volatile("v_cvt_pk_bf16_f32 %0, %1, %2" : "=v"(r) : "v"(lo), "v"(hi)); return r; }
typedef float f32x2 __attribute__((ext_vector_type(2)));
__device__ __forceinline__ f32x2 gelu_pk(f32x2 v) {
    const f32x2 av = __builtin_elementwise_abs(v), d = av * 0.2316418882f + 1.0f;
    f32x2 t; t.x = __builtin_amdgcn_rcpf(d.x); t.y = __builtin_amdgcn_rcpf(d.y);
    f32x2 q = t * 0.5307027145f + (-0.7265760135f); q = q * t + 0.7107068705f; q = q * t + (-0.142248368f); q = q * t + 0.127414796f; q = q * t;
    const f32x2 s = (v * v) * (-0.72134752044f);
    f32x2 e; e.x = __builtin_amdgcn_exp2f(s.x); e.y = __builtin_amdgcn_exp2f(s.y);
    const f32x2 m = v * (q * e), r = v - m;
    f32x2 o; o.x = v.x < 0.f ? m.x : r.x; o.y = v.y < 0.f ? m.y : r.y; return o;
}

template <int ACT  > struct EpiBf16 {
    static constexpr bool PERM = true, AFTER_DRAIN = false, IDEM = true; static_assert(ACT == 0 || ACT == 1, "EpiBf16: ACT is 0 (none) or 1 (gelu_pk)");
    bf16_t* O; int ldc; const float* bias; int split_cols; size_t split_stride; float scale0;
    __device__ __forceinline__ void operator()(const f32x4 (&acc)[2][2][4][2], const Unit& u, int wr, int wc, int fr, int fq) const {
        const int row0 = u.pm * BM + wr * 64 + fr; int colt = u.pn * BM; bf16_t* base = O;
        float sc = 1.f; if (split_cols) { const int t = colt / split_cols; base += (size_t)t * split_stride; colt -= t * split_cols; if (t == 0) sc = scale0; }
        const int col0 = colt + wc * 32 + 8 * fq, bcol0 = u.pn * BM + wc * 32 + 8 * fq;
        f32x4 bv[2][2];
#pragma unroll
        for (int bj = 0; bj < 2; ++bj)
#pragma unroll
            for (int n = 0; n < 2; ++n) bv[bj][n] = bias ? *(const f32x4*)(bias + bcol0 + bj * HALF + 4 * n) : (f32x4){0.f, 0.f, 0.f, 0.f};
#pragma unroll
        for (int ai = 0; ai < 2; ++ai)
#pragma unroll
            for (int m = 0; m < 4; ++m) { bf16_t* rowp = base + (size_t)(row0 + ai * HALF + m * 16) * ldc + col0;
#pragma unroll
                for (int bj = 0; bj < 2; ++bj) { f32x4 v0 = acc[ai][bj][m][0] + bv[bj][0], v1 = acc[ai][bj][m][1] + bv[bj][1];
                    if (ACT == 1) { f32x2 a = gelu_pk((f32x2){v0[0], v0[1]}), b = gelu_pk((f32x2){v0[2], v0[3]}), c = gelu_pk((f32x2){v1[0], v1[1]}), d = gelu_pk((f32x2){v1[2], v1[3]});
                        v0 = (f32x4){a.x, a.y, b.x, b.y}; v1 = (f32x4){c.x, c.y, d.x, d.y}; }
                    v0 = v0 * sc; v1 = v1 * sc; u32x4 w; w.x = cvt_pk_bf16(v0[0], v0[1]); w.y = cvt_pk_bf16(v0[2], v0[3]); w.z = cvt_pk_bf16(v1[0], v1[1]); w.w = cvt_pk_bf16(v1[2], v1[3]);
                    *(u32x4*)(rowp + bj * HALF) = w; } }
    }
};
template <class Epi, class Sched, bool ALIGN_EPI = false, bool SP2 = false, bool F8 = false, bool BLK = false>
__device__ __forceinline__ void gemm_phase(PG8_LAS unsigned char* lds, const Gemm g, const Sched& S, const Epi& E) {
    const int tid = threadIdx.x, wid = __builtin_amdgcn_readfirstlane(tid >> 6), lane = tid & 63, wr = wid >> 2, wc = wid & 3, fr = lane & 15, fq = lane >> 4;
    const int K = g.K, nt = K / BK;
    unsigned voffA[2], voffB[2];
#pragma unroll
    for (int i = 0; i < 2; ++i) { int R, C; stage_rc(tid * 16 + i * 8192, R, C); const int Rb = Epi::PERM ? ((R & ~31) + perm32(R & 31)) : R;
        voffA[i] = BLK ? (unsigned)(R * 64 + C) * 2u : (unsigned)(R * K + C) * 2u; voffB[i] = BLK ? (unsigned)(Rb * 64 + C) * 2u : (unsigned)(Rb * K + C) * 2u; }
    const size_t kstep = BLK ? (size_t)32768 : (size_t)(BK * 2);
    const size_t hstep = BLK ? (size_t)16384 : (size_t)HALF * K * 2;
    const size_t tstep = BLK ? (size_t)(g.kt_full ? g.kt_full : nt) * 32768 : 2 * hstep;
    const size_t sstep = BLK ? (size_t)nt * 32768 : 0;
    const unsigned ldsw = (unsigned)wid * 1024u;
    const int aoff = lds_byte(wr * 64 + fr, fq * 8), boff = lds_byte(wc * 32 + fr, fq * 8);
#define PG8_SA(b, h) (((b) * 2 + (h)) * HTB)
#define PG8_SB(b, h) ((4 + (b) * 2 + (h)) * HTB)
#define PG8_STAGE(bufoff, gbase, voff) do { _Pragma("unroll") for (int _i = 0; _i < 2; ++_i) \
        __builtin_amdgcn_global_load_lds((const unsigned*)((const char*)(gbase) + (voff)[_i]), (PG8_LAS unsigned*)(lds + (bufoff) + ldsw + _i * 8192), 16, 0, 0); } while (0)
#define PG8_LDA(dst, b, h) do { if constexpr (F8) { _Pragma("unroll") for (int m = 0; m < 4; ++m) dst##_8[m] = __builtin_shufflevector(*(const PG8_LAS v4i_t*)(lds + PG8_SA(b, h) + aoff + m * 2048), *(const PG8_LAS v4i_t*)(lds + PG8_SA(b, h) + aoff + m * 2048 + 1024), 0, 1, 2, 3, 4, 5, 6, 7); } \
        else { _Pragma("unroll") for (int m = 0; m < 4; ++m) _Pragma("unroll") for (int k = 0; k < 2; ++k) dst[m][k] = *(const PG8_LAS bf16x8*)(lds + PG8_SA(b, h) + aoff + m * 2048 + k * 1024); } } while (0)
#define PG8_LDB(dst, b, h) do { if constexpr (F8) { _Pragma("unroll") for (int n = 0; n < 2; ++n) dst##_8[n] = __builtin_shufflevector(*(const PG8_LAS v4i_t*)(lds + PG8_SB(b, h) + boff + n * 2048), *(const PG8_LAS v4i_t*)(lds + PG8_SB(b, h) + boff + n * 2048 + 1024), 0, 1, 2, 3, 4, 5, 6, 7); } \
        else { _Pragma("unroll") for (int n = 0; n < 2; ++n) _Pragma("unroll") for (int k = 0; k < 2; ++k) dst[n][k] = *(const PG8_LAS bf16x8*)(lds + PG8_SB(b, h) + boff + n * 2048 + k * 1024); } } while (0)
#define PG8_MMA(ai, bj, At, Bt) do { __builtin_amdgcn_s_setprio(1); \
        if constexpr (F8) { _Pragma("unroll") for (int m = 0; m < 4; ++m) _Pragma("unroll") for (int n = 0; n < 2; ++n) \
            asm volatile("v_mfma_scale_f32_16x16x128_f8f6f4 %0, %1, %2, %0, %3, %3 op_sel_hi:[0,0,0]" : "+v"(acc[ai][bj][m][n]) : "v"(Bt##_8[n]), "v"(At##_8[m]), "v"(f8sc)); }   \
        else { _Pragma("unroll") for (int m = 0; m < 4; ++m) _Pragma("unroll") for (int n = 0; n < 2; ++n) _Pragma("unroll") for (int k = 0; k < 2; ++k) \
            acc[ai][bj][m][n] = __builtin_amdgcn_mfma_f32_16x16x32_bf16(Bt[n][k], At[m][k], acc[ai][bj][m][n], 0, 0, 0); } \
        __builtin_amdgcn_s_setprio(0); } while (0)
#define PG8_WAIT_V(n) asm volatile("s_waitcnt vmcnt(" #n ")" ::: "memory")
#define PG8_WAIT_L(n) asm volatile("s_waitcnt lgkmcnt(" #n ")" ::: "memory")
#define PG8_BAR __builtin_amdgcn_s_barrier()
#define PG8_SCHED __builtin_amdgcn_sched_barrier(0)
    Unit cur, nxt; int ui = 0;
    if (!S.next(0, cur)) return;
    f32x4 acc[2][2][4][2];
#pragma unroll
    for (int a = 0; a < 2; ++a)
#pragma unroll
        for (int b = 0; b < 2; ++b)
#pragma unroll
            for (int m = 0; m < 4; ++m)
#pragma unroll
                for (int n = 0; n < 2; ++n) acc[a][b][m][n] = (f32x4){0.f, 0.f, 0.f, 0.f};
    const int f8sc = 0x7f7f7f7f;
    bf16x8 At[4][2], B0[2][2], B1[2][2]; v8i_t At_8[4], B0_8[2], B1_8[2];
    const char* cA = (const char*)g.A + (size_t)cur.pm * tstep + (size_t)cur.ks * sstep; const char* cB = (const char*)g.Bt + S.bofs(cur) + (size_t)cur.pn * tstep + (size_t)cur.ks * sstep;
    S.a_ready(cur);
    if constexpr (SP2) {
        PG8_STAGE(PG8_SB(0, 0), cB, voffB); PG8_STAGE(PG8_SB(0, 1), cB + hstep, voffB); PG8_STAGE(PG8_SA(0, 0), cA, voffA); PG8_STAGE(PG8_SA(0, 1), cA + hstep, voffA);
        if (wr == 1) PG8_BAR;
        PG8_WAIT_V(2); PG8_BAR;
        PG8_STAGE(PG8_SB(1, 0), cB + kstep, voffB); PG8_STAGE(PG8_SA(1, 0), cA + kstep, voffA); PG8_STAGE(PG8_SB(1, 1), cB + hstep + kstep, voffB);
        PG8_WAIT_V(6); PG8_BAR;
    } else {
        PG8_STAGE(PG8_SB(0, 0), cB, voffB); PG8_STAGE(PG8_SA(0, 0), cA, voffA); PG8_STAGE(PG8_SB(0, 1), cB + hstep, voffB); PG8_STAGE(PG8_SA(0, 1), cA + hstep, voffA);
        if (wr == 1) PG8_BAR;
        PG8_WAIT_V(4); PG8_BAR;
        PG8_STAGE(PG8_SB(1, 0), cB + kstep, voffB); PG8_STAGE(PG8_SA(1, 0), cA + kstep, voffA); PG8_STAGE(PG8_SB(1, 1), cB + hstep + kstep, voffB);
        PG8_WAIT_V(6); PG8_BAR;
    }
    for (;;) {
        const bool has_next = S.next(ui + 1, nxt);
        const char* nA = has_next ? (const char*)g.A + (size_t)nxt.pm * tstep + (size_t)nxt.ks * sstep : cA; const char* nB = has_next ? (const char*)g.Bt + S.bofs(nxt) + (size_t)nxt.pn * tstep + (size_t)nxt.ks * sstep : cB;
#pragma nounroll
        for (int t = 0; t < nt; t += 2) {
            const bool last = (t == nt - 2);
            const char* a1 = cA + (size_t)(t + 1) * kstep;
            const char* a2 = last ? nA : cA + (size_t)(t + 2) * kstep; const char* b2 = last ? nB : cB + (size_t)(t + 2) * kstep;
            const char* a3 = a2 + kstep; const char* b3 = b2 + kstep;
            if (last && has_next) S.a_ready(nxt);
            if constexpr (SP2) {
            PG8_LDB(B0, 0, 0); PG8_LDB(B1, 0, 1); PG8_SCHED; PG8_LDA(At, 0, 0); PG8_STAGE(PG8_SA(1, 1), a1 + hstep, voffA);
            PG8_WAIT_V(8); PG8_WAIT_L(0); PG8_BAR; PG8_MMA(0, 0, At, B0); PG8_MMA(0, 1, At, B1); PG8_BAR; PG8_SCHED;
            PG8_LDA(At, 0, 1); PG8_STAGE(PG8_SB(0, 0), b2, voffB); PG8_STAGE(PG8_SB(0, 1), b2 + hstep, voffB); PG8_STAGE(PG8_SA(0, 0), a2, voffA);
            PG8_WAIT_V(8); PG8_WAIT_L(0); PG8_BAR; PG8_MMA(1, 0, At, B0); PG8_MMA(1, 1, At, B1); PG8_BAR; PG8_SCHED;
            PG8_LDB(B0, 1, 0); PG8_LDB(B1, 1, 1); PG8_SCHED; PG8_LDA(At, 1, 0); PG8_STAGE(PG8_SA(0, 1), a2 + hstep, voffA);
            PG8_WAIT_V(8); PG8_WAIT_L(0); PG8_BAR; PG8_MMA(0, 0, At, B0); PG8_MMA(0, 1, At, B1); PG8_BAR; PG8_SCHED;
            PG8_LDA(At, 1, 1); PG8_STAGE(PG8_SB(1, 0), b3, voffB); PG8_STAGE(PG8_SB(1, 1), b3 + hstep, voffB); PG8_STAGE(PG8_SA(1, 0), a3, voffA);
            PG8_WAIT_V(8); PG8_WAIT_L(0); PG8_BAR; PG8_MMA(1, 0, At, B0); PG8_MMA(1, 1, At, B1); PG8_BAR; PG8_SCHED;
            } else {
            PG8_LDB(B0, 0, 0); PG8_SCHED; PG8_LDA(At, 0, 0); PG8_STAGE(PG8_SA(1, 1), a1 + hstep, voffA);
            PG8_WAIT_L(8); PG8_BAR; PG8_WAIT_L(0); PG8_MMA(0, 0, At, B0); PG8_BAR; PG8_SCHED;
            PG8_LDB(B1, 0, 1); PG8_STAGE(PG8_SB(0, 0), b2, voffB);
            PG8_BAR; PG8_WAIT_L(0); PG8_MMA(0, 1, At, B1); PG8_BAR;
            PG8_LDA(At, 0, 1); PG8_STAGE(PG8_SA(0, 0), a2, voffA);
            PG8_BAR; PG8_WAIT_L(0); PG8_MMA(1, 0, At, B0); PG8_BAR; PG8_SCHED;
            PG8_STAGE(PG8_SB(0, 1), b2 + hstep, voffB);
            PG8_WAIT_V(6); PG8_BAR; PG8_MMA(1, 1, At, B1); PG8_BAR;
            PG8_LDB(B0, 1, 0); PG8_SCHED; PG8_LDA(At, 1, 0); PG8_STAGE(PG8_SA(0, 1), a2 + hstep, voffA);
            PG8_WAIT_L(8); PG8_BAR; PG8_WAIT_L(0); PG8_MMA(0, 0, At, B0); PG8_BAR; PG8_SCHED;
            PG8_LDB(B1, 1, 1); PG8_STAGE(PG8_SB(1, 0), b3, voffB);
            PG8_BAR; PG8_WAIT_L(0); PG8_MMA(0, 1, At, B1); PG8_BAR;
            PG8_LDA(At, 1, 1); PG8_STAGE(PG8_SA(1, 0), a3, voffA);
            PG8_BAR; PG8_WAIT_L(0); PG8_MMA(1, 0, At, B0); PG8_BAR; PG8_SCHED;
            PG8_STAGE(PG8_SB(1, 1), b3 + hstep, voffB);
            PG8_WAIT_V(6); PG8_BAR; PG8_MMA(1, 1, At, B1); PG8_BAR;
            }
        }
        if constexpr (F8) asm volatile("s_nop 15\n\ts_nop 15\n\ts_nop 15\n\ts_nop 15\n\ts_nop 15" ::: "memory");
        if constexpr (ALIGN_EPI) { if (wr == 0) PG8_BAR; }
        if constexpr (!Epi::AFTER_DRAIN) { for (int er_ = 0; er_ < (Epi::IDEM ? EPI_REP : 1); ++er_) E(acc, cur, wr, wc, fr, fq); S.done(cur); }
        if (!has_next) break;
#pragma unroll
        for (int a = 0; a < 2; ++a)
#pragma unroll
            for (int b = 0; b < 2; ++b)
#pragma unroll
                for (int m = 0; m < 4; ++m)
#pragma unroll
                    for (int n = 0; n < 2; ++n) acc[a][b][m][n] = (f32x4){0.f, 0.f, 0.f, 0.f};
        cur = nxt; cA = nA; cB = nB; ++ui;
        if constexpr (ALIGN_EPI) { if (wr == 1) PG8_BAR; }
    }
    PG8_WAIT_V(0);
    if constexpr (!ALIGN_EPI) { if (wr == 0) PG8_BAR; }
    PG8_BAR;
    if constexpr (Epi::AFTER_DRAIN) { E.fused(acc, cur, wr, wc, fr, fq, lds, wid, lane); S.done(cur); }
#undef PG8_SA
#undef PG8_SB
#undef PG8_STAGE
#undef PG8_LDA
#undef PG8_LDB
#undef PG8_MMA
#undef PG8_WAIT_V
#undef PG8_WAIT_L
#undef PG8_BAR
#undef PG8_SCHED
}
}

#define LAS __attribute__((address_space(3)))
typedef unsigned short bf16;
typedef short bf16x8 __attribute__((ext_vector_type(8)));
typedef float f32x4 __attribute__((ext_vector_type(4)));
typedef float f32x16 __attribute__((ext_vector_type(16)));
typedef unsigned u32x4 __attribute__((ext_vector_type(4)));
typedef unsigned u32x2 __attribute__((ext_vector_type(2)));

constexpr int NB = 4, SEQ = 8192, T = NB * SEQ, D = 1024, DEPTH = 2;
constexpr int INC = 2560, IN_COLS = 2544;
constexpr int U_CQ = 0, U_CKV = 192, U_KPE = 320, U_NQ = 352, U_NKV = 608, U_NG = 992, U_LX = 1008, U_LG = 1264,
              U_SZ = 1520, U_SX = 1776, U_SB = 2032, U_SC = 2288, U_SDT = 2544;
constexpr int DFF = 3584, NEXP = 8;
constexpr float EPS = 1e-6f;
#ifndef INPROJ_F8
#define INPROJ_F8 0
#endif
constexpr float F8_H = 16.f, F8_WGU = 256.f, F8_ACT = 8.f, F8_WD = 512.f;
constexpr int NWAVES = 8, NTHR = 512;
constexpr int LDS_BYTES = 163840;
constexpr int LDS_MISC = 163840 - 1024;

enum { I_X = 0, I_POS, I_NORM_MIX, I_W_IN, I_MLA_QN, I_MLA_WUQ, I_MLA_KVN, I_MLA_WUKV, I_NSA_PE, I_NSA_WCMP, I_LRU_CW, I_LRU_CB, I_LRU_WG, I_LRU_BG,
       I_LRU_LAM, I_SSD_CW, I_SSD_CB, I_SSD_DTB, I_SSD_ALOG, I_SSD_D, I_GNORM, I_W_OUT, I_NORM_FFN, I_FFN_WG, I_FFN_WU, I_FFN_WD, I_MOE_R, I_MOE_WG,
       I_MOE_WU, I_MOE_WD, I_NORM_FINAL, N_IN };

constexpr size_t MiB = 1u << 20;
constexpr size_t WS_CTL = 0, CTL_BYTES = 1 * MiB;
constexpr size_t WS_WIN = 1 * MiB;
constexpr size_t WS_WOUT = 11 * MiB;
constexpr size_t WS_FGU = 15 * MiB;
constexpr size_t WS_FD = 29 * MiB;
constexpr size_t WS_MISC = 36 * MiB;
constexpr size_t WS_WUQ = WS_MISC;
constexpr size_t WS_WUKV = WS_WUQ + 2 * 384 * 192 * 2;
constexpr size_t WS_WCT = WS_WUKV + 2 * 512 * 128 * 2;
constexpr size_t WS_BIASC = WS_WCT + 4 * 64 * 2048 * 2;
constexpr size_t WS_WGT = WS_BIASC + 4 * 64 * 4;
constexpr size_t WS_ROPEM = WS_MISC + 2 * MiB;
constexpr size_t WS_ROPEN = WS_MISC + 3 * MiB;
static_assert(WS_WGT + 2 * 2 * 4 * 64 * 64 * 2 <= WS_ROPEM, "misc weights");
constexpr size_t WS_ARENA = 42 * MiB;
constexpr size_t WS_U = WS_ARENA;
constexpr size_t WS_Y = 202 * MiB;
constexpr size_t WS_HN = 266 * MiB;
constexpr size_t WS_MQ = 330 * MiB, WS_MK = 354 * MiB, WS_MVT = 378 * MiB;
constexpr size_t WS_NQ = 394 * MiB, WS_NKS = 410 * MiB, WS_NKW = 414 * MiB, WS_NVTS = 418 * MiB, WS_NVTW = 422 * MiB, WS_NKC = 426 * MiB, WS_NVCT = 427 * MiB, WS_NGATE = 428 * MiB;
constexpr size_t WS_LHL = 430 * MiB, WS_LPC = 446 * MiB, WS_LACH = 462 * MiB, WS_LHCH = WS_LACH + 512 * 1024, WS_LCIN = WS_LHCH + 512 * 1024;
constexpr size_t WS_SST = 464 * MiB, WS_STT = 496 * MiB;
constexpr size_t WS_SHIN = WS_HN;
constexpr size_t WS_MRAW = WS_HN + 32 * MiB;
constexpr size_t WS_DELTA = 160 * MiB;
constexpr size_t WS_ACT = WS_ARENA;
constexpr size_t WS_END = 512 * MiB;

constexpr int CW_BAR = 4096;
constexpr int CW_Q = 8192;
constexpr int CW_KMAX_UNUSED = 10240;

__device__ __forceinline__ float bf2f(bf16 v) { return __uint_as_float(((unsigned)v) << 16); }

typedef float f32x2_t __attribute__((ext_vector_type(2))); typedef __bf16 bf16x2_t __attribute__((ext_vector_type(2)));
__device__ __forceinline__ unsigned pk2(float lo, float hi) { f32x2_t v = {lo, hi}; bf16x2_t b = __builtin_convertvector(v, bf16x2_t); return __builtin_bit_cast(unsigned, b); }
__device__ __forceinline__ unsigned f2bf(float f) { return pk2(f, 0.f) & 0xffffu; }
__device__ __forceinline__ float lo_bf(unsigned w) { return __uint_as_float(w << 16); }
__device__ __forceinline__ float hi_bf(unsigned w) { return __uint_as_float(w & 0xffff0000u); }
__device__ __forceinline__ int crow(int r, int hi) { return (r & 3) + 8 * (r >> 2) + 4 * hi; }
#define MFMA32(a, b, c) __builtin_amdgcn_mfma_f32_32x32x16_bf16(a, b, c, 0, 0, 0)
#define MFMA16(a, b, c) __builtin_amdgcn_mfma_f32_16x16x32_bf16(a, b, c, 0, 0, 0)
#define LDS_WAIT() asm volatile("s_waitcnt lgkmcnt(0)" ::: "memory")
#define WG_BAR() do { asm volatile("s_waitcnt lgkmcnt(0)" ::: "memory"); __builtin_amdgcn_s_barrier(); asm volatile("" ::: "memory"); } while (0)
__device__ __forceinline__ float wave_sum(float v) {
#pragma unroll
    for (int o = 1; o < 64; o <<= 1) v += __shfl_xor(v, o);
    return v;
}
constexpr int CW_KMG = 16384, KM_WORDS = 96;
__device__ __forceinline__ void kmax_update(LAS unsigned* kml, int word, float v) { __hip_atomic_fetch_max(kml + word, __float_as_uint(v), __ATOMIC_RELAXED, __HIP_MEMORY_SCOPE_WORKGROUP); }
__device__ __forceinline__ float kmax_read(const unsigned char* ws, int l, int word, int lane, int G) {
    const unsigned* p = (const unsigned*)(ws + WS_CTL) + CW_KMG + (size_t)(l * KM_WORDS + word) * 256; unsigned m = 0u;
    for (int i = lane; i < G && i < 256; i += 64) { const unsigned v = p[i]; m = v > m ? v : m; }
#pragma unroll
    for (int o = 1; o < 64; o <<= 1) { const unsigned t = (unsigned)__shfl_xor((int)m, o); m = t > m ? t : m; }
    return __uint_as_float(m);
}
__device__ __forceinline__ float sigmoidf_(float x) { return __builtin_amdgcn_rcpf(1.0f + __expf(-x)); }

#define XB_TMO      128
#define XB_XCNT(j)  (256  + 64 * (j))
#define XB_XSUB(j)  (1280 + 64 * (j))
#define XB_XGEN(j)  (2304 + 64 * (j))
#define XB_TOP      3328
#define XB_TOPGEN   3392
#define XCD_BAR_WORDS 3456
#define XB_SPIN_CAP (1u << 18)
__device__ __forceinline__ unsigned xb_ld(unsigned* p)              { return __hip_atomic_load(p, __ATOMIC_RELAXED, __HIP_MEMORY_SCOPE_AGENT); }
__device__ __forceinline__ unsigned xb_add(unsigned* p, unsigned v) { return __hip_atomic_fetch_add(p, v, __ATOMIC_RELAXED, __HIP_MEMORY_SCOPE_AGENT); }
__device__ __forceinline__ unsigned xb_xcc_id() { return (unsigned)__builtin_amdgcn_s_getreg((3 << 11) | 20) & 0xFu; }
#define XB_SPIN(cond, bar) do { unsigned _sp = 0; while (cond) { __builtin_amdgcn_s_sleep(1); \
    if ((++_sp & 255u) == 0u) { if (xb_ld(&(bar)[XB_TMO])) break; if (_sp > XB_SPIN_CAP) { atomicAdd(&(bar)[XB_TMO], 1u); break; } } } } while (0)
struct XcdBarrier { unsigned* bar; unsigned x; volatile LAS unsigned* st; };
__device__ __forceinline__ XcdBarrier xcd_barrier_post(unsigned* bar, volatile LAS unsigned* st) {
    XcdBarrier b; b.bar = bar; b.x = xb_xcc_id(); b.st = st;
    if (threadIdx.x == 0) (void)xb_add(&bar[XB_XCNT(b.x)], 1u);
    return b;
}
__device__ __forceinline__ void xcd_barrier_complete(unsigned* bar, unsigned x, unsigned& nloc, unsigned& nx) {
    const unsigned G = gridDim.x * gridDim.y * gridDim.z;
    unsigned sum, cnt, mine, sp = 0u;
    for (;;) {
        sum = 0u; cnt = 0u; mine = 0u;
#pragma unroll
        for (unsigned j = 0; j < 16; ++j) { const unsigned c = xb_ld(&bar[XB_XCNT(j)]); sum += c; cnt += (c > 0u) ? 1u : 0u; mine = (j == x) ? c : mine; }
        if (sum == G) break;
        __builtin_amdgcn_s_sleep(1);
        if ((++sp & 255u) == 0u) { if (xb_ld(&bar[XB_TMO])) break; if (sp > XB_SPIN_CAP) { atomicAdd(&bar[XB_TMO], 1u); break; } }
    }
    nloc = mine > 0u ? mine : 1u; nx = cnt > 0u ? cnt : 1u;
}
__device__ __forceinline__ void xcd_barrier(const XcdBarrier& b) {
    asm volatile("s_waitcnt vmcnt(0)" ::: "memory");
    __syncthreads();
    if (threadIdx.x == 0) {
        unsigned* bar = b.bar;
        __builtin_amdgcn_s_waitcnt(0);
        unsigned nloc = b.st[0], nx = b.st[1];
        if (nloc == 0u) { xcd_barrier_complete(bar, b.x, nloc, nx); b.st[0] = nloc; b.st[1] = nx; }
        const unsigned old = xb_add(&bar[XB_XSUB(b.x)], 1u);
        const unsigned gen = old / nloc;
        if (old + 1u == (gen + 1u) * nloc) {
            __builtin_amdgcn_fence(__ATOMIC_RELEASE, "agent");
            asm volatile("s_waitcnt vmcnt(0)" ::: "memory");
            const unsigned og = xb_add(&bar[XB_TOP], 1u);
            const unsigned tg = og / nx;
            if (og + 1u == (tg + 1u) * nx) xb_add(&bar[XB_TOPGEN], 1u);
            else XB_SPIN(xb_ld(&bar[XB_TOPGEN]) == tg, bar);
            __builtin_amdgcn_fence(__ATOMIC_ACQUIRE, "agent");
            xb_add(&bar[XB_XGEN(b.x)], 1u);
            asm volatile("s_waitcnt vmcnt(0)" ::: "memory");
        } else {
            XB_SPIN(xb_ld(&bar[XB_XGEN(b.x)]) == gen, bar);
            __builtin_amdgcn_fence(__ATOMIC_ACQUIRE, "agent");
            asm volatile("s_waitcnt vmcnt(0)" ::: "memory");
        }
    }
    __syncthreads();
}

struct Args { const void* in[N_IN]; float* out; unsigned char* ws; int ph_lo, ph_hi; };
#define INF(i) ((const float*)A.in[i])

namespace pg8 {
struct EpiResF32 {
    static constexpr bool PERM = false, AFTER_DRAIN = false, IDEM = false;
    const float* base; float* out; int ldc; float scale;
    __device__ __forceinline__ void operator()(const f32x4 (&acc)[2][2][4][2], const Unit& u, int wr, int wc, int fr, int fq) const {
        const int row0 = u.pm * BM + wr * 64 + fr, col0 = u.pn * BM + wc * 32 + 4 * fq;
#pragma unroll
        for (int ai = 0; ai < 2; ++ai)
#pragma unroll
            for (int m = 0; m < 4; ++m) { const size_t off = (size_t)(row0 + ai * HALF + m * 16) * ldc + col0;
#pragma unroll
                for (int bj = 0; bj < 2; ++bj)
#pragma unroll
                    for (int n = 0; n < 2; ++n) { const f32x4 bs = *(const f32x4*)(base + off + bj * HALF + n * 16); *(f32x4*)(out + off + bj * HALF + n * 16) = bs + acc[ai][bj][m][n] * scale; }
                asm volatile("" ::: "memory"); }
    }
};
struct EpiSwiglu {
    static constexpr bool PERM = true, AFTER_DRAIN = false, IDEM = true;
    bf16_t* O; int ldc;
    __device__ __forceinline__ void operator()(const f32x4 (&acc)[2][2][4][2], const Unit& u, int wr, int wc, int fr, int fq) const {
        const int row0 = u.pm * BM + wr * 64 + fr, col0 = u.pn * HALF + wc * 32 + 8 * fq;
#pragma unroll
        for (int ai = 0; ai < 2; ++ai)
#pragma unroll
            for (int m = 0; m < 4; ++m) { bf16_t* rowp = O + (size_t)(row0 + ai * HALF + m * 16) * ldc + col0;
                float v[8];
#pragma unroll
                for (int n = 0; n < 2; ++n)
#pragma unroll
                    for (int j = 0; j < 4; ++j) { const float g = acc[ai][0][m][n][j], up = acc[ai][1][m][n][j]; v[4 * n + j] = g * up * __builtin_amdgcn_rcpf(1.0f + __expf(-g)); }
                u32x4 w; w.x = cvt_pk_bf16(v[0], v[1]); w.y = cvt_pk_bf16(v[2], v[3]); w.z = cvt_pk_bf16(v[4], v[5]); w.w = cvt_pk_bf16(v[6], v[7]);
                *(u32x4*)rowp = w; }
    }
};
struct EpiBf16S {
    static constexpr bool PERM = true, AFTER_DRAIN = false, IDEM = true;
    bf16_t* O; int ldc; float scale;
    __device__ __forceinline__ void operator()(const f32x4 (&acc)[2][2][4][2], const Unit& u, int wr, int wc, int fr, int fq) const {
        const int row0 = u.pm * BM + wr * 64 + fr, col0 = u.pn * BM + wc * 32 + 8 * fq;
#pragma unroll
        for (int ai = 0; ai < 2; ++ai)
#pragma unroll
            for (int m = 0; m < 4; ++m) { bf16_t* rowp = O + (size_t)(row0 + ai * HALF + m * 16) * ldc + col0;
#pragma unroll
                for (int bj = 0; bj < 2; ++bj) { const f32x4 v0 = acc[ai][bj][m][0] * scale, v1 = acc[ai][bj][m][1] * scale;
                    u32x4 w; w.x = cvt_pk_bf16(v0[0], v0[1]); w.y = cvt_pk_bf16(v0[2], v0[3]); w.z = cvt_pk_bf16(v1[0], v1[1]); w.w = cvt_pk_bf16(v1[2], v1[3]);
                    *(u32x4*)(rowp + bj * HALF) = w; } }
    }
};
struct EpiSwiglu8 {
    static constexpr bool PERM = true, AFTER_DRAIN = false, IDEM = true;
    unsigned char* O; int nkt; float s_in, s_out;
    __device__ __forceinline__ void operator()(const f32x4 (&acc)[2][2][4][2], const Unit& u, int wr, int wc, int fr, int fq) const {
        unsigned char* const Ob = O + ((size_t)(u.pm * nkt + u.pn) * 256 + wr * 64 + fr) * 128 + wc * 32 + 8 * fq;
#pragma unroll
        for (int ai = 0; ai < 2; ++ai)
#pragma unroll
            for (int m = 0; m < 4; ++m) { unsigned char* rowp = Ob + (ai * HALF + m * 16) * 128;
                float v[8];
#pragma unroll
                for (int n = 0; n < 2; ++n)
#pragma unroll
                    for (int j = 0; j < 4; ++j) { const float g = acc[ai][0][m][n][j] * s_in, up = acc[ai][1][m][n][j] * s_in; v[4 * n + j] = fminf(fmaxf(g * up * __builtin_amdgcn_rcpf(1.0f + __expf(-g)) * s_out, -448.f), 448.f); }
                int p0 = 0, p1 = 0; p0 = __builtin_amdgcn_cvt_pk_fp8_f32(v[0], v[1], p0, false); p0 = __builtin_amdgcn_cvt_pk_fp8_f32(v[2], v[3], p0, true);
                p1 = __builtin_amdgcn_cvt_pk_fp8_f32(v[4], v[5], p1, false); p1 = __builtin_amdgcn_cvt_pk_fp8_f32(v[6], v[7], p1, true);
                u32x2 w; w.x = (unsigned)p0; w.y = (unsigned)p1; *(u32x2*)rowp = w; }
    }
};
}

struct SrcMap {
    const float* W0; long long d1; int mode; int N;
    __device__ __forceinline__ const float* col(int nd) const {
        if (mode == 0) return nd < N ? W0 + nd : nullptr;
        if (mode == 1) { if (nd < 1004) return W0 + nd; if (nd < 1008 || nd >= 2548) return nullptr; return W0 + (nd - 4); }
        const int tile = nd >> 8, w = nd & 255, f = tile * 128 + (w & 127); return W0 + (w < 128 ? 0ll : d1) + f;
    }
};
__device__ __forceinline__ void transpose_item(const SrcMap sm, int ldw, int K, bf16* WT, LAS float* scr, int kb, int nb, int lane) {
    const int k0 = 64 * kb, n0 = 32 * nb;
    const float* colp = sm.col(n0 + (lane & 31));
    float v[32];
#pragma unroll
    for (int i = 0; i < 32; ++i) { const int kk = 2 * i + (lane >> 5); v[i] = colp ? __builtin_nontemporal_load(colp + (size_t)(k0 + kk) * ldw) : 0.f; }
#pragma unroll
    for (int i = 0; i < 32; ++i) { const int kk = 2 * i + (lane >> 5); scr[kk * 33 + (lane & 31)] = v[i]; }
    LDS_WAIT();
    const int c = lane & 7;
#pragma unroll
    for (int j = 0; j < 4; ++j) { const int n = (lane >> 3) + 8 * j; const LAS float* s = scr + (8 * c) * 33 + n;
        u32x4 o; o.x = pk2(s[0 * 33], s[1 * 33]); o.y = pk2(s[2 * 33], s[3 * 33]); o.z = pk2(s[4 * 33], s[5 * 33]); o.w = pk2(s[6 * 33], s[7 * 33]);
        *(u32x4*)(WT + (size_t)(n0 + n) * K + k0 + 8 * c) = o; }
    LDS_WAIT();
}
__device__ __forceinline__ unsigned pk4_fp8(float a, float b, float c, float d) { int p = 0; p = __builtin_amdgcn_cvt_pk_fp8_f32(a, b, p, false); p = __builtin_amdgcn_cvt_pk_fp8_f32(c, d, p, true); return (unsigned)p; }
__device__ __forceinline__ float clamp8(float x) { return fminf(fmaxf(x, -448.f), 448.f); }
__device__ __forceinline__ void transpose_item8(const SrcMap sm, int ldw, int K, unsigned char* WT8, float scale, LAS float* scr, int kb, int nb, int lane, int blk = 0) {
    const int k0 = 64 * kb, n0 = 32 * nb;
    const float* colp = sm.col(n0 + (lane & 31));
    float v[32];
#pragma unroll
    for (int i = 0; i < 32; ++i) { const int kk = 2 * i + (lane >> 5); v[i] = colp ? __builtin_nontemporal_load(colp + (size_t)(k0 + kk) * ldw) : 0.f; }
#pragma unroll
    for (int i = 0; i < 32; ++i) { const int kk = 2 * i + (lane >> 5); scr[kk * 33 + (lane & 31)] = v[i]; }
    LDS_WAIT();
    const int n = lane >> 1, h32 = (lane & 1) * 32; const LAS float* s = scr + h32 * 33 + n;
    u32x4 o0, o1;
    o0.x = pk4_fp8(clamp8(s[0 * 33] * scale), clamp8(s[1 * 33] * scale), clamp8(s[2 * 33] * scale), clamp8(s[3 * 33] * scale)); o0.y = pk4_fp8(clamp8(s[4 * 33] * scale), clamp8(s[5 * 33] * scale), clamp8(s[6 * 33] * scale), clamp8(s[7 * 33] * scale));
    o0.z = pk4_fp8(clamp8(s[8 * 33] * scale), clamp8(s[9 * 33] * scale), clamp8(s[10 * 33] * scale), clamp8(s[11 * 33] * scale)); o0.w = pk4_fp8(clamp8(s[12 * 33] * scale), clamp8(s[13 * 33] * scale), clamp8(s[14 * 33] * scale), clamp8(s[15 * 33] * scale));
    o1.x = pk4_fp8(clamp8(s[16 * 33] * scale), clamp8(s[17 * 33] * scale), clamp8(s[18 * 33] * scale), clamp8(s[19 * 33] * scale)); o1.y = pk4_fp8(clamp8(s[20 * 33] * scale), clamp8(s[21 * 33] * scale), clamp8(s[22 * 33] * scale), clamp8(s[23 * 33] * scale));
    o1.z = pk4_fp8(clamp8(s[24 * 33] * scale), clamp8(s[25 * 33] * scale), clamp8(s[26 * 33] * scale), clamp8(s[27 * 33] * scale)); o1.w = pk4_fp8(clamp8(s[28 * 33] * scale), clamp8(s[29 * 33] * scale), clamp8(s[30 * 33] * scale), clamp8(s[31 * 33] * scale));
    const int nr = n0 + n; unsigned char* dst = blk ? WT8 + ((size_t)((nr >> 8) * (K >> 7) + (k0 >> 7)) * 256 + (nr & 255)) * 128 + (k0 & 127) + h32 : WT8 + (size_t)nr * K + k0 + h32;
    *(u32x4*)dst = o0; *(u32x4*)(dst + 16) = o1;
    LDS_WAIT();
}
__device__ __forceinline__ void transpose_matrix8(const SrcMap sm, int ldw, int K, int Ndst, unsigned char* WT8, float scale, LAS float* scr, int gw, int ngw, int lane, int blk = 0) {
    const int nkb = K / 64, nnb = Ndst / 32, nit = nkb * nnb;
    for (int it = gw; it < nit; it += ngw) transpose_item8(sm, ldw, K, WT8, scale, scr, it / nnb, it % nnb, lane, blk);
}
__device__ __forceinline__ void transpose_matrix(const SrcMap sm, int ldw, int K, int Ndst, bf16* WT, LAS float* scr, int gw, int ngw, int lane) {
    const int nkb = K / 64, nnb = Ndst / 32, nit = nkb * nnb;
    for (int it = gw; it < nit; it += ngw) transpose_item(sm, ldw, K, WT, scr, it / nnb, it % nnb, lane);
}
__device__ __forceinline__ void rms_row_to_bf16(const float* xrow, const float* g, bf16* orow, int lane) {
    const f32x4* xr = (const f32x4*)xrow + lane; const f32x4* gr = (const f32x4*)g + lane;
    f32x4 v[4]; float s = 0.f;
#pragma unroll
    for (int j = 0; j < 4; ++j) { v[j] = xr[64 * j]; s += (v[j].x * v[j].x + v[j].y * v[j].y) + (v[j].z * v[j].z + v[j].w * v[j].w); }
    const float rs = __builtin_amdgcn_rsqf(wave_sum(s) * (1.f / D) + EPS);
    unsigned long long* o8 = (unsigned long long*)orow + lane;
#pragma unroll
    for (int j = 0; j < 4; ++j) { const f32x4 gg = gr[64 * j];
        o8[64 * j] = (unsigned long long)pk2(v[j].x * rs * gg.x, v[j].y * rs * gg.y) | ((unsigned long long)pk2(v[j].z * rs * gg.z, v[j].w * rs * gg.w) << 32); }
}
__device__ __forceinline__ void phase_norm_rows8(const float* X, const float* g, unsigned char* O, float scale, int gw, int ngw, int lane) {
    for (int m = gw; m < T; m += ngw) {
        const f32x4* xr = (const f32x4*)(X + (size_t)m * D) + lane; const f32x4* gr = (const f32x4*)g + lane;
        f32x4 v[4]; float s = 0.f;
#pragma unroll
        for (int j = 0; j < 4; ++j) { v[j] = xr[64 * j]; s += (v[j].x * v[j].x + v[j].y * v[j].y) + (v[j].z * v[j].z + v[j].w * v[j].w); }
        const float rs = scale / sqrtf(wave_sum(s) * (1.f / D) + EPS);
        unsigned* o4 = (unsigned*)(O + (size_t)m * D) + lane;
#pragma unroll
        for (int j = 0; j < 4; ++j) { const f32x4 gg = gr[64 * j]; o4[64 * j] = pk4_fp8(clamp8(v[j].x * rs * gg.x), clamp8(v[j].y * rs * gg.y), clamp8(v[j].z * rs * gg.z), clamp8(v[j].w * rs * gg.w)); }
    }
}
__device__ __forceinline__ void phase_add_norm_rows(float* X, const bf16* Dl, const float* g, bf16* O, int gw, int ngw, int lane) {
    for (int m = gw; m < T; m += ngw) {
        f32x4* xr = (f32x4*)(X + (size_t)m * D) + lane; const f32x4* gr = (const f32x4*)g + lane; const u32x2* dr = (const u32x2*)(Dl + (size_t)m * D) + lane;
        f32x4 v[4]; float s = 0.f;
#pragma unroll
        for (int j = 0; j < 4; ++j) { const u32x2 d = dr[64 * j]; v[j] = xr[64 * j]; v[j].x += lo_bf(d.x); v[j].y += hi_bf(d.x); v[j].z += lo_bf(d.y); v[j].w += hi_bf(d.y);
            s += (v[j].x * v[j].x + v[j].y * v[j].y) + (v[j].z * v[j].z + v[j].w * v[j].w); }
        const float rs = __builtin_amdgcn_rsqf(wave_sum(s) * (1.f / D) + EPS);
        unsigned long long* o8 = (unsigned long long*)(O + (size_t)m * D) + lane;
#pragma unroll
        for (int j = 0; j < 4; ++j) { const f32x4 gg = gr[64 * j]; xr[64 * j] = v[j];
            o8[64 * j] = (unsigned long long)pk2(v[j].x * rs * gg.x, v[j].y * rs * gg.y) | ((unsigned long long)pk2(v[j].z * rs * gg.z, v[j].w * rs * gg.w) << 32); }
    }
}
__device__ __forceinline__ void phase_norm_rows(const float* X, const float* g, bf16* O, int gw, int ngw, int lane) {
    int m = gw;
    for (; m + 3 * ngw < T; m += 4 * ngw) {
        f32x4 v[4][4]; float s[4];
#pragma unroll
        for (int q = 0; q < 4; ++q) { const f32x4* xr = (const f32x4*)(X + (size_t)(m + q * ngw) * D) + lane;
#pragma unroll
            for (int j = 0; j < 4; ++j) v[q][j] = xr[64 * j]; }
#pragma unroll
        for (int q = 0; q < 4; ++q) { s[q] = 0.f;
#pragma unroll
            for (int j = 0; j < 4; ++j) s[q] += (v[q][j].x * v[q][j].x + v[q][j].y * v[q][j].y) + (v[q][j].z * v[q][j].z + v[q][j].w * v[q][j].w); }
#pragma unroll
        for (int q = 0; q < 4; ++q) { const float rs = __builtin_amdgcn_rsqf(wave_sum(s[q]) * (1.f / D) + EPS); const f32x4* gr = (const f32x4*)g + lane;
            unsigned long long* o8 = (unsigned long long*)(O + (size_t)(m + q * ngw) * D) + lane;
#pragma unroll
            for (int j = 0; j < 4; ++j) { const f32x4 gg = gr[64 * j];
                o8[64 * j] = (unsigned long long)pk2(v[q][j].x * rs * gg.x, v[q][j].y * rs * gg.y) | ((unsigned long long)pk2(v[q][j].z * rs * gg.z, v[q][j].w * rs * gg.w) << 32); } }
    }
    for (; m < T; m += ngw) rms_row_to_bf16(X + (size_t)m * D, g, O + (size_t)m * D, lane);
}
__device__ __forceinline__ void phase_final_norm(float* X, const float* g, int gw, int ngw, int lane) {
    for (int m = gw; m < T; m += ngw) {
        f32x4* xr = (f32x4*)(X + (size_t)m * D) + lane; const f32x4* gr = (const f32x4*)g + lane;
        f32x4 v[4]; float s = 0.f;
#pragma unroll
        for (int j = 0; j < 4; ++j) { v[j] = xr[64 * j]; s += (v[j].x * v[j].x + v[j].y * v[j].y) + (v[j].z * v[j].z + v[j].w * v[j].w); }
        const float rs = __builtin_amdgcn_rsqf(wave_sum(s) * (1.f / D) + EPS);
#pragma unroll
        for (int j = 0; j < 4; ++j) xr[64 * j] = v[j] * rs * gr[64 * j];
    }
}

__device__ __forceinline__ void phase_prep_weights(const Args& A, LAS unsigned char* lds, int gw, int ngw, int wave, int lane) {
    unsigned char* ws = A.ws;
    LAS float* scr = (LAS float*)(lds + wave * 16384);
    for (int l = 0; l < DEPTH; ++l) {
#if INPROJ_F8
        transpose_matrix8(SrcMap{INF(I_W_IN) + (size_t)l * D * IN_COLS, 0, 1, IN_COLS}, IN_COLS, D, INC, ws + WS_WIN + (size_t)l * INC * D, F8_WGU, scr, gw, ngw, lane);
#else
        transpose_matrix(SrcMap{INF(I_W_IN) + (size_t)l * D * IN_COLS, 0, 1, IN_COLS}, IN_COLS, D, INC, (bf16*)(ws + WS_WIN) + (size_t)l * INC * D, scr, gw, ngw, lane);
#endif
        transpose_matrix(SrcMap{INF(I_W_OUT) + (size_t)l * D * D, 0, 0, D}, D, D, D, (bf16*)(ws + WS_WOUT) + (size_t)l * D * D, scr, gw, ngw, lane);
        transpose_matrix(SrcMap{INF(I_MLA_WUQ) + (size_t)l * 192 * 384, 0, 0, 384}, 384, 192, 384, (bf16*)(ws + WS_WUQ) + (size_t)l * 384 * 192, scr, gw, ngw, lane);
        transpose_matrix(SrcMap{INF(I_MLA_WUKV) + (size_t)l * 128 * 512, 0, 0, 512}, 512, 128, 512, (bf16*)(ws + WS_WUKV) + (size_t)l * 512 * 128, scr, gw, ngw, lane);
        for (int kv = 0; kv < 2; ++kv)
            transpose_matrix(SrcMap{INF(I_NSA_WCMP) + (size_t)(l * 2 + kv) * 2048 * 64, 0, 0, 64}, 64, 2048, 64, (bf16*)(ws + WS_WCT) + (size_t)(l * 2 + kv) * 64 * 2048, scr, gw, ngw, lane);
        for (int gn = 0; gn < 8; ++gn)
            transpose_matrix(SrcMap{INF(I_LRU_WG) + (size_t)(l * 8 + gn) * 64 * 64, 0, 0, 64}, 64, 64, 64, (bf16*)(ws + WS_WGT) + (size_t)(l * 8 + gn) * 64 * 64, scr, gw, ngw, lane);
    }
    transpose_matrix8(SrcMap{INF(I_FFN_WG), (long long)(INF(I_FFN_WU) - INF(I_FFN_WG)), 2, DFF}, DFF, D, 2 * DFF, ws + WS_FGU, F8_WGU, scr, gw, ngw, lane);
    transpose_matrix8(SrcMap{INF(I_FFN_WD), 0, 0, D}, D, DFF, D, ws + WS_FD, F8_WD, scr, gw, ngw, lane, 1);
    if (gw < 256) { const int m4 = gw >> 6, o = gw & 63; const float* pe = INF(I_NSA_PE) + (size_t)m4 * 2048; const float* w = INF(I_NSA_WCMP) + (size_t)m4 * 2048 * 64 + o; float s = 0.f;
#pragma unroll 8
        for (int k = lane; k < 2048; k += 64) s += pe[k] * w[(size_t)k * 64];
        s = wave_sum(s);
        if (lane == 0) ((float*)(ws + WS_BIASC))[m4 * 64 + o] = s; }
    { const int* pos = (const int*)A.in[I_POS]; float* cm = (float*)(ws + WS_ROPEM); float* sm_ = cm + SEQ * 16; float* cn = (float*)(ws + WS_ROPEN); float* sn = cn + SEQ * 8;
      for (int i = gw * 64 + lane; i < SEQ * 16; i += ngw * 64) { const int s = i >> 4, j = i & 15; const float inv = powf(500000.0f, -(float)(2 * j) / 32.0f); const float ang = (float)pos[s] * inv; cm[i] = cosf(ang); sm_[i] = sinf(ang); }
      for (int i = gw * 64 + lane; i < SEQ * 8; i += ngw * 64) { const int s = i >> 3, j = i & 7; const float inv = powf(500000.0f, -(float)(2 * j) / 16.0f); const float ang = (float)pos[s] * inv; cn[i] = cosf(ang); sn[i] = sinf(ang); } }
}

template <int NROWS, int NCH16> __device__ __forceinline__ void load_rows_lds(const bf16* ub  , int s_first, LAS unsigned char* dst, int tid) {
    constexpr int NCHUNK = NROWS * NCH16, PER = (NCHUNK + NTHR - 1) / NTHR;
    u32x4 r[PER];
#pragma unroll
    for (int i = 0; i < PER; ++i) { int ci = tid + i * NTHR; ci = ci < NCHUNK ? ci : NCHUNK - 1; const int row = ci / NCH16, ch = ci % NCH16, sr = s_first + row;
        r[i] = *(const u32x4*)(ub + (size_t)(sr < 0 ? 0 : sr) * INC + 8 * ch); if (sr < 0) r[i] = (u32x4){0u, 0u, 0u, 0u}; }
#pragma unroll
    for (int i = 0; i < PER; ++i) { const int ci = tid + i * NTHR; if (ci < NCHUNK) { const int row = ci / NCH16, ch = ci % NCH16; *(LAS u32x4*)(dst + row * (16 * NCH16 + 16) + 16 * ch) = r[i]; } }
}
__device__ __forceinline__ void lru_local_tile(const Args& A, int l, int tile, LAS unsigned char* lds) {
    unsigned char* ws = A.ws;
    int tid = threadIdx.x; asm volatile("" : "+v"(tid)); const int lane = tid & 63, wid = __builtin_amdgcn_readfirstlane(tid >> 6);
    const int tok0 = tile * 64, b = tok0 / SEQ, s0 = tok0 % SEQ;
    LAS float* XF = (LAS float*)lds; LAS float* AS = (LAS float*)(lds + 32768); LAS bf16* XH = (LAS bf16*)(lds + 65536);
    const bf16* U = (const bf16*)(ws + WS_U);
    const int c = tid & 255, tg = tid >> 8;
    const float* cw = INF(I_LRU_CW) + (size_t)l * 4 * 256; const float cw0 = cw[c], cw1 = cw[256 + c], cw2 = cw[512 + c], cw3 = cw[768 + c], cb = INF(I_LRU_CB)[l * 256 + c];
    float h = 0.f, P = 1.f;
    LAS unsigned char* RAW = lds + 82432;
    load_rows_lds<67, 32>(U + (size_t)(b * SEQ) * INC + U_LX, s0 - 3, RAW, tid);
    WG_BAR();
    for (int hh = 0; hh < 2; ++hh) {
        {
            const LAS bf16* rp = (const LAS bf16*)(RAW + (32 * hh + 16 * tg) * 528) + c;
            float xm3 = bf2f(rp[0]), xm2 = bf2f(rp[264]), xm1 = bf2f(rp[528]);
#pragma unroll
            for (int i = 0; i < 16; ++i) { const float x0 = bf2f(rp[(i + 3) * 264]); const float v = cb + cw0 * xm3 + cw1 * xm2 + cw2 * xm1 + cw3 * x0;
                XF[(16 * tg + i) * 256 + c] = v; XH[(16 * tg + i) * 264 + c] = (bf16)f2bf(v); xm3 = xm2; xm2 = xm1; xm1 = x0; }
        }
        WG_BAR();
        {
            const int n = wid & 3, db = wid >> 2, r32 = lane & 31, hi = lane >> 5;
            f32x16 g0 = {}, g1 = {};
            const bf16* w0 = (const bf16*)(ws + WS_WGT) + ((size_t)((l * 2 + 0) * 4 + n) * 64 + 32 * db + r32) * 64 + hi * 8;
            const bf16* w1 = (const bf16*)(ws + WS_WGT) + ((size_t)((l * 2 + 1) * 4 + n) * 64 + 32 * db + r32) * 64 + hi * 8;
#pragma unroll
            for (int ks = 0; ks < 4; ++ks) { const bf16x8 a = *(const LAS bf16x8*)(XH + r32 * 264 + 64 * n + 16 * ks + 8 * hi);
                const bf16x8 b0 = *(const bf16x8*)(w0 + 16 * ks), b1 = *(const bf16x8*)(w1 + 16 * ks);
                g0 = MFMA32(a, b0, g0); g1 = MFMA32(a, b1, g1); }
            const int d = 64 * n + 32 * db + r32;
            const float bg0 = INF(I_LRU_BG)[(l * 2 + 0) * 256 + d], bg1 = INF(I_LRU_BG)[(l * 2 + 1) * 256 + d];
            const float lam = INF(I_LRU_LAM)[l * 256 + d]; const float sp = log1pf(__expf(-lam));
#pragma unroll
            for (int r = 0; r < 16; ++r) { const int t = crow(r, hi); const float rr = sigmoidf_(g0[r] + bg0), ii = sigmoidf_(g1[r] + bg1);
                const float la = -8.0f * rr * sp; const float a_ = __expf(la); const float x2 = 2.0f * la;
                const float om = x2 > -0.02f ? -x2 * (1.0f + 0.5f * x2 * (1.0f + x2 * (1.0f / 3.0f))) : 1.0f - a_ * a_;
                const float bb = __builtin_amdgcn_sqrtf(fmaxf(om, 0.f)) * ii * XF[t * 256 + d];
                AS[t * 256 + d] = a_; XF[t * 256 + d] = bb; }
        }
        WG_BAR();
        if (tid < 256) {
            bf16* HL = (bf16*)(ws + WS_LHL) + (size_t)(tok0 + 32 * hh) * 256 + c; bf16* PC = (bf16*)(ws + WS_LPC) + (size_t)(tok0 + 32 * hh) * 256 + c;
#pragma unroll 8
            for (int t = 0; t < 32; ++t) { const float a_ = AS[t * 256 + c], b_ = XF[t * 256 + c]; h = a_ * h + b_; P *= a_; HL[(size_t)t * 256] = (bf16)f2bf(h); PC[(size_t)t * 256] = (bf16)f2bf(P); }
        }
        WG_BAR();
    }
    if (tid < 256) { ((float*)(ws + WS_LACH))[tile * 256 + c] = P; ((float*)(ws + WS_LHCH))[tile * 256 + c] = h; }
}
__device__ __forceinline__ void lru_carry_unit(const Args& A, int b) {
    unsigned char* ws = A.ws; const int c = threadIdx.x;
    if (c < 256) { const float* ach = (const float*)(ws + WS_LACH) + (size_t)b * 128 * 256 + c; const float* hch = (const float*)(ws + WS_LHCH) + (size_t)b * 128 * 256 + c; float* cin = (float*)(ws + WS_LCIN) + (size_t)b * 128 * 256 + c;
        float carry = 0.f;
#pragma unroll 8
        for (int ch = 0; ch < 128; ++ch) { cin[ch * 256] = carry; carry = ach[ch * 256] * carry + hch[ch * 256]; } }
}
__device__ __forceinline__ float gelu_tanh(float x) { const float u = 0.7978845608028654f * (x + 0.044715f * x * x * x); return x * __builtin_amdgcn_rcpf(1.0f + __expf(-2.0f * u)); }
__device__ __forceinline__ void lru_final_tile(const Args& A, int l, int tile) {
    unsigned char* ws = A.ws; int tid = threadIdx.x; asm volatile("" : "+v"(tid)); const int tt = tid >> 3, sub = tid & 7; const int tok = tile * 64 + tt, c0 = sub * 32;
    const u32x4* hl = (const u32x4*)((const bf16*)(ws + WS_LHL) + (size_t)tok * 256 + c0); const u32x4* pc = (const u32x4*)((const bf16*)(ws + WS_LPC) + (size_t)tok * 256 + c0);
    const f32x4* cin = (const f32x4*)((const float*)(ws + WS_LCIN) + (size_t)tile * 256 + c0); const u32x4* gb = (const u32x4*)((const bf16*)(ws + WS_U) + (size_t)tok * INC + U_LG + c0);
    const f32x4* gn = (const f32x4*)(INF(I_GNORM) + (size_t)(l * 4 + 2) * 256 + c0);
    float o[32]; float ss = 0.f;
#pragma unroll
    for (int q = 0; q < 4; ++q) { const u32x4 hv = hl[q], pv = pc[q], gv = gb[q]; const f32x4 c0v = cin[2 * q], c1v = cin[2 * q + 1];
        const unsigned hw[4] = {hv.x, hv.y, hv.z, hv.w}, pw[4] = {pv.x, pv.y, pv.z, pv.w}, gw_[4] = {gv.x, gv.y, gv.z, gv.w}; const float cc[8] = {c0v.x, c0v.y, c0v.z, c0v.w, c1v.x, c1v.y, c1v.z, c1v.w};
#pragma unroll
        for (int j = 0; j < 4; ++j) { const float h0 = lo_bf(hw[j]) + lo_bf(pw[j]) * cc[2 * j], h1 = hi_bf(hw[j]) + hi_bf(pw[j]) * cc[2 * j + 1];
            const float v0 = h0 * gelu_tanh(lo_bf(gw_[j])), v1 = h1 * gelu_tanh(hi_bf(gw_[j])); o[8 * q + 2 * j] = v0; o[8 * q + 2 * j + 1] = v1; ss += v0 * v0 + v1 * v1; } }
    ss += __shfl_xor(ss, 1); ss += __shfl_xor(ss, 2); ss += __shfl_xor(ss, 4);
    const float rs = __builtin_amdgcn_rsqf(ss * (1.f / 256.f) + EPS);
    u32x4* yo = (u32x4*)((bf16*)(ws + WS_Y) + (size_t)tok * D + 512 + c0);
#pragma unroll
    for (int q = 0; q < 4; ++q) { const f32x4 g0 = gn[2 * q], g1 = gn[2 * q + 1]; u32x4 w;
        w.x = pk2(o[8 * q + 0] * rs * g0.x, o[8 * q + 1] * rs * g0.y); w.y = pk2(o[8 * q + 2] * rs * g0.z, o[8 * q + 3] * rs * g0.w);
        w.z = pk2(o[8 * q + 4] * rs * g1.x, o[8 * q + 5] * rs * g1.y); w.w = pk2(o[8 * q + 6] * rs * g1.z, o[8 * q + 7] * rs * g1.w); yo[q] = w; }
}

struct ConvState { float xm3, xm2, xm1; };
__device__ __forceinline__ void conv_init(ConvState& st, const bf16* up, int s) {
    st.xm3 = (s - 3 >= 0) ? bf2f(up[(size_t)(s - 3) * INC]) : 0.f; st.xm2 = (s - 2 >= 0) ? bf2f(up[(size_t)(s - 2) * INC]) : 0.f; st.xm1 = (s - 1 >= 0) ? bf2f(up[(size_t)(s - 1) * INC]) : 0.f; }
__device__ __forceinline__ float conv_step(ConvState& st, const bf16* up, int s, float w0, float w1, float w2, float w3, float cb) {
    const float x0 = bf2f(up[(size_t)s * INC]); const float v = cb + w0 * st.xm3 + w1 * st.xm2 + w2 * st.xm1 + w3 * x0; st.xm3 = st.xm2; st.xm2 = st.xm1; st.xm1 = x0; return v; }
template <int NT> __device__ __forceinline__ void conv_load(float (&x)[NT + 3], const bf16* up, int s) {
#pragma unroll
    for (int i = 0; i < NT + 3; ++i) { const int t = s - 3 + i; const unsigned short r = up[(size_t)(t < 0 ? 0 : t) * INC]; x[i] = t < 0 ? 0.f : bf2f(r); }
}
__device__ __forceinline__ float siluf_(float v) { return v * __builtin_amdgcn_rcpf(1.0f + __expf(-v)); }
__device__ __forceinline__ float softplusf_(float x) { return fmaxf(x, 0.f) + log1pf(__expf(-fabsf(x))); }
__device__ __forceinline__ int perm16pos(int l) { return (l & ~15) | (((l >> 2) & 1) << 3) | (((l >> 3) & 1) << 2) | (l & 3); }
__device__ __forceinline__ void ssd_dt_scan(const Args& A, int l, int h, const bf16* Ub, int s0, int lane, float& dt0, float& dt1, float& acs0, float& acs1, float& Ttot) {
    const float dtb = INF(I_SSD_DTB)[l * 4 + h], Ah = -__expf(INF(I_SSD_ALOG)[l * 4 + h]);
    const float r0 = bf2f(Ub[(size_t)(s0 + 2 * lane) * INC + U_SDT + h]), r1 = bf2f(Ub[(size_t)(s0 + 2 * lane + 1) * INC + U_SDT + h]);
    dt0 = softplusf_(r0 + dtb); dt1 = softplusf_(r1 + dtb);
    const float dA0 = dt0 * Ah, dA1 = dt1 * Ah, s = dA0 + dA1; float incl = s;
#pragma unroll
    for (int o = 1; o < 64; o <<= 1) { const float t = __shfl_up(incl, o); if (lane >= o) incl += t; }
    acs0 = incl - s + dA0; acs1 = incl; Ttot = __shfl(incl, 63);
}
__device__ __forceinline__ void ssd_state_unit(const Args& A, int l, int unit, LAS unsigned char* lds) {
    unsigned char* ws = A.ws;
    int tid = threadIdx.x; asm volatile("" : "+v"(tid)); const int lane = tid & 63, wid = __builtin_amdgcn_readfirstlane(tid >> 6), r32 = lane & 31, hi = lane >> 5;
    const int g = unit & 1, bc = unit >> 1, b = bc >> 6, chunk = bc & 63, s0 = chunk * 128;
    LAS bf16* XdT = (LAS bf16*)lds; LAS bf16* BT = (LAS bf16*)(lds + 34816); LAS float* WL = (LAS float*)(lds + 69632);
    const bf16* Ub = (const bf16*)(ws + WS_U) + (size_t)(b * SEQ) * INC;
    LAS unsigned char* RAWX = lds + 71680; LAS unsigned char* RAWB = lds + 107520;
    load_rows_lds<131, 16>(Ub + U_SX + g * 128, s0 - 3, RAWX, tid);
    load_rows_lds<131, 16>(Ub + U_SB + g * 128, s0 - 3, RAWB, tid);
    if (wid < 2) { float dt0, dt1, a0, a1, Tt; ssd_dt_scan(A, l, 2 * g + wid, Ub, s0, lane, dt0, dt1, a0, a1, Tt);
        WL[wid * 128 + 2 * lane] = dt0 * __expf(Tt - a0); WL[wid * 128 + 2 * lane + 1] = dt1 * __expf(Tt - a1);
        if (lane == 0) ((float*)(ws + WS_STT))[bc * 4 + 2 * g + wid] = Tt; }
    WG_BAR();
    {   const int chn = tid & 255, tg = tid >> 8; const bool isx = chn < 128; const int cc = chn & 127, ch768 = isx ? g * 128 + cc : 256 + g * 128 + cc;
        const float* cw = INF(I_SSD_CW) + (size_t)l * 4 * 768 + ch768; const float w0 = cw[0], w1 = cw[768], w2 = cw[1536], w3 = cw[2304], cb = INF(I_SSD_CB)[l * 768 + ch768];
        LAS bf16* dst = isx ? XdT + cc * 136 : BT + cc * 136; const LAS float* wl = WL + ((chn >> 6) & 1) * 128;
        const LAS bf16* rp = (const LAS bf16*)((isx ? RAWX : RAWB) + (64 * tg) * 272) + cc;
        float xm3 = bf2f(rp[0]), xm2 = bf2f(rp[136]), xm1 = bf2f(rp[272]);
        for (int i8 = 0; i8 < 8; ++i8) { float v[8];
#pragma unroll
            for (int j = 0; j < 8; ++j) { const int q = 8 * i8 + j, tt = 64 * tg + q; const float x0 = bf2f(rp[(q + 3) * 136]); float x = siluf_(cb + w0 * xm3 + w1 * xm2 + w2 * xm1 + w3 * x0); xm3 = xm2; xm2 = xm1; xm1 = x0; if (isx) x *= wl[tt]; v[j] = x; }
            u32x4 o; o.x = pk2(v[0], v[1]); o.y = pk2(v[2], v[3]); o.z = pk2(v[4], v[5]); o.w = pk2(v[6], v[7]);
            *(LAS u32x4*)(dst + 64 * tg + 8 * i8) = o; }
    }
    WG_BAR();
    {   const int hh = wid >> 2, nb = wid & 3; f32x16 acc[2] = {};
#pragma unroll
        for (int ks = 0; ks < 8; ++ks) { const bf16x8 bf = *(const LAS bf16x8*)(BT + (32 * nb + r32) * 136 + 16 * ks + 8 * hi);
#pragma unroll
            for (int pb = 0; pb < 2; ++pb) { const bf16x8 af = *(const LAS bf16x8*)(XdT + (hh * 64 + 32 * pb + r32) * 136 + 16 * ks + 8 * hi); acc[pb] = MFMA32(af, bf, acc[pb]); } }
        float* S = (float*)(ws + WS_SST) + (size_t)(bc * 4 + 2 * g + hh) * 8192 + 32 * nb + r32;
#pragma unroll
        for (int pb = 0; pb < 2; ++pb)
#pragma unroll
            for (int r = 0; r < 16; ++r) S[(size_t)(32 * pb + crow(r, hi)) * 128] = acc[pb][r];
    }
    WG_BAR();
}
__device__ __forceinline__ void ssd_prop_unit(const Args& A, int unit) {
    unsigned char* ws = A.ws; const int bh = unit >> 2, sl = unit & 3, b = bh >> 2, h = bh & 3;
    const size_t eoff = (size_t)(b * 64 * 4 + h) * 8192 + sl * 2048 + threadIdx.x * 4;
    const float* base = (const float*)(ws + WS_SST) + eoff; float* hout = (float*)(ws + WS_SHIN) + eoff; const float* tt = (const float*)(ws + WS_STT) + b * 64 * 4 + h;
    f32x4 carry = {0.f, 0.f, 0.f, 0.f};
    f32x4 sv[8], nsv[8]; float tv[8], ntv[8];
#pragma unroll
    for (int j = 0; j < 8; ++j) { sv[j] = *(const f32x4*)(base + (size_t)j * 4 * 8192); tv[j] = tt[j * 4]; }
#pragma unroll
    for (int z0 = 0; z0 < 64; z0 += 8) {
        if (z0 + 8 < 64) {
#pragma unroll
            for (int j = 0; j < 8; ++j) { nsv[j] = *(const f32x4*)(base + (size_t)(z0 + 8 + j) * 4 * 8192); ntv[j] = tt[(z0 + 8 + j) * 4]; } }
        __builtin_amdgcn_sched_barrier(0);
#pragma unroll
        for (int j = 0; j < 8; ++j) { *(f32x4*)(hout + (size_t)(z0 + j) * 4 * 8192) = carry; carry = carry * __expf(tv[j]) + sv[j]; }
        __builtin_amdgcn_sched_barrier(0);
#pragma unroll
        for (int j = 0; j < 8; ++j) { sv[j] = nsv[j]; tv[j] = ntv[j]; }
    }
}
__device__ __forceinline__ void ssd_final_unit(const Args& A, int l, int bc, LAS unsigned char* lds) {
    unsigned char* ws = A.ws;
    int tid = threadIdx.x; asm volatile("" : "+v"(tid)); const int lane = tid & 63, wid = __builtin_amdgcn_readfirstlane(tid >> 6), r32 = lane & 31, hi = lane >> 5;
    const int b = bc >> 6, chunk = bc & 63, s0 = chunk * 128;
    LAS bf16* Bs = (LAS bf16*)lds; LAS bf16* Cs = (LAS bf16*)(lds + 34816); LAS bf16* XT = (LAS bf16*)(lds + 69632); LAS bf16* Hs = (LAS bf16*)(lds + 104448);
    LAS float* ACS = (LAS float*)(lds + 140288); LAS float* DTV = ACS + 256; LAS float* SSQ = DTV + 256;
    const bf16* Ub = (const bf16*)(ws + WS_U) + (size_t)(b * SEQ) * INC;
    const int lb = wid & 3, hh = wid >> 2, lq = 32 * lb + r32;
    f32x16 yk[2][2];
#pragma unroll
    for (int g = 0; g < 2; ++g) {
        if (wid < 2) { float dt0, dt1, a0, a1, Tt; ssd_dt_scan(A, l, 2 * g + wid, Ub, s0, lane, dt0, dt1, a0, a1, Tt);
            ACS[wid * 128 + 2 * lane] = a0; ACS[wid * 128 + 2 * lane + 1] = a1; DTV[wid * 128 + 2 * lane] = dt0; DTV[wid * 128 + 2 * lane + 1] = dt1; }
#pragma unroll 1
        for (int kind = 0; kind < 3; ++kind) {
            LAS unsigned char* RAW = lds + 104448;
            load_rows_lds<131, 16>(Ub + U_SX + kind * 256 + g * 128, s0 - 3, RAW, tid);
            WG_BAR();
            const int cc = tid & 127, tq = tid >> 7, ch768 = kind * 256 + g * 128 + cc;
            const float* cw = INF(I_SSD_CW) + (size_t)l * 4 * 768 + ch768; const float w0 = cw[0], w1 = cw[768], w2 = cw[1536], w3 = cw[2304], cb = INF(I_SSD_CB)[l * 768 + ch768];
            const LAS bf16* rp = (const LAS bf16*)(RAW + (32 * tq) * 272) + cc;
            float xm3 = bf2f(rp[0]), xm2 = bf2f(rp[136]), xm1 = bf2f(rp[272]);
#pragma unroll
            for (int half = 0; half < 2; ++half) { float v[16]; const int t0 = 32 * tq + 16 * half;
#pragma unroll
                for (int j = 0; j < 16; ++j) { const float x0 = bf2f(rp[(16 * half + j + 3) * 136]); v[j] = siluf_(cb + w0 * xm3 + w1 * xm2 + w2 * xm1 + w3 * x0); xm3 = xm2; xm2 = xm1; xm1 = x0; }
                if (kind == 0) { u32x4 o0, o1; o0.x = pk2(v[0], v[1]); o0.y = pk2(v[2], v[3]); o0.z = pk2(v[8], v[9]); o0.w = pk2(v[10], v[11]);
                    o1.x = pk2(v[4], v[5]); o1.y = pk2(v[6], v[7]); o1.z = pk2(v[12], v[13]); o1.w = pk2(v[14], v[15]);
                    *(LAS u32x4*)(XT + cc * 136 + t0) = o0; *(LAS u32x4*)(XT + cc * 136 + t0 + 8) = o1; }
                else { LAS bf16* dst = (kind == 1 ? Bs : Cs) + t0 * 136 + cc;
#pragma unroll
                    for (int j = 0; j < 16; ++j) dst[j * 136] = (bf16)f2bf(v[j]); } }
            WG_BAR();
        }
        {   const int row = tid >> 2, q4 = tid & 3; const float* src = (const float*)(ws + WS_SHIN) + ((size_t)(bc * 4 + 2 * g + (row >> 6)) * 64 + (row & 63)) * 128 + q4 * 32;
#pragma unroll
            for (int q = 0; q < 4; ++q) { const f32x4 a = *(const f32x4*)(src + 8 * q), c = *(const f32x4*)(src + 8 * q + 4); u32x4 o; o.x = pk2(a.x, a.y); o.y = pk2(a.z, a.w); o.z = pk2(c.x, c.y); o.w = pk2(c.z, c.w);
                *(LAS u32x4*)(Hs + row * 136 + q4 * 32 + 8 * q) = o; } }
        WG_BAR();
        {   const int h = 2 * g + hh;
            bf16x8 cf[8];
#pragma unroll
            for (int ks = 0; ks < 8; ++ks) cf[ks] = *(const LAS bf16x8*)(Cs + lq * 136 + 16 * ks + 8 * hi);
            f32x16 ya[2] = {};
            const float acs_l = ACS[hh * 128 + lq];
            for (int st = 0; st <= (lb >> 1); ++st) {
                f32x16 G0 = {}, G1 = {};
#pragma unroll
                for (int ks = 0; ks < 8; ++ks) { const bf16x8 a0 = *(const LAS bf16x8*)(Bs + (64 * st + r32) * 136 + 16 * ks + 8 * hi), a1 = *(const LAS bf16x8*)(Bs + (64 * st + 32 + r32) * 136 + 16 * ks + 8 * hi);
                    G0 = MFMA32(a0, cf[ks], G0); G1 = MFMA32(a1, cf[ks], G1); }
#pragma unroll
                for (int r = 0; r < 16; ++r) { const int sa = 64 * st + crow(r, hi), sb = sa + 32;
                    const float wa = (sa <= lq) ? __expf(acs_l - ACS[hh * 128 + sa]) * DTV[hh * 128 + sa] : 0.f, wb = (sb <= lq) ? __expf(acs_l - ACS[hh * 128 + sb]) * DTV[hh * 128 + sb] : 0.f;
                    G0[r] *= wa; G1[r] *= wb; }
                bf16x8 pk[4];
#pragma unroll
                for (int sp = 0; sp < 4; ++sp) { u32x4 w;
                    if (sp < 2) { w.x = pk2(G0[8 * sp + 0], G0[8 * sp + 1]); w.y = pk2(G0[8 * sp + 2], G0[8 * sp + 3]); w.z = pk2(G0[8 * sp + 4], G0[8 * sp + 5]); w.w = pk2(G0[8 * sp + 6], G0[8 * sp + 7]); }
                    else { const int q = sp - 2; w.x = pk2(G1[8 * q + 0], G1[8 * q + 1]); w.y = pk2(G1[8 * q + 2], G1[8 * q + 3]); w.z = pk2(G1[8 * q + 4], G1[8 * q + 5]); w.w = pk2(G1[8 * q + 6], G1[8 * q + 7]); }
                    pk[sp] = __builtin_bit_cast(bf16x8, w); }
#pragma unroll
                for (int pb = 0; pb < 2; ++pb)
#pragma unroll
                    for (int sp = 0; sp < 4; ++sp) { const bf16x8 a = *(const LAS bf16x8*)(XT + (hh * 64 + 32 * pb + r32) * 136 + 64 * st + 16 * sp + 8 * hi); ya[pb] = MFMA32(a, pk[sp], ya[pb]); }
            }
            f32x16 yo[2] = {};
#pragma unroll
            for (int ks = 0; ks < 8; ++ks)
#pragma unroll
                for (int pb = 0; pb < 2; ++pb) { const bf16x8 a = *(const LAS bf16x8*)(Hs + (hh * 64 + 32 * pb + r32) * 136 + 16 * ks + 8 * hi); yo[pb] = MFMA32(a, cf[ks], yo[pb]); }
            const float e = __expf(acs_l), Dh = INF(I_SSD_D)[l * 4 + h]; float ss = 0.f; const int lp = perm16pos(lq);
#pragma unroll
            for (int pb = 0; pb < 2; ++pb)
#pragma unroll
                for (int r4 = 0; r4 < 4; ++r4) { const int p0 = 32 * pb + 8 * r4 + 4 * hi;
                    const u32x2 zz = *(const u32x2*)(Ub + (size_t)(s0 + lq) * INC + U_SZ + h * 64 + p0); const float zv[4] = {lo_bf(zz.x), hi_bf(zz.x), lo_bf(zz.y), hi_bf(zz.y)};
#pragma unroll
                    for (int j = 0; j < 4; ++j) { const int r = 4 * r4 + j; const float xs = bf2f(XT[(hh * 64 + p0 + j) * 136 + lp]);
                        const float val = (ya[pb][r] + yo[pb][r] * e + Dh * xs) * siluf_(zv[j]); ya[pb][r] = val; ss += val * val; } }
            ss += __shfl_xor(ss, 32); if (hi == 0) SSQ[lq * 4 + h] = ss;
            yk[g][0] = ya[0]; yk[g][1] = ya[1];
        }
        WG_BAR();
    }
    const float rs = __builtin_amdgcn_rsqf((SSQ[lq * 4 + 0] + SSQ[lq * 4 + 1] + SSQ[lq * 4 + 2] + SSQ[lq * 4 + 3]) * (1.f / 256.f) + EPS);
    bf16* yrow = (bf16*)(ws + WS_Y) + (size_t)(b * SEQ + s0 + lq) * D + 768;
#pragma unroll
    for (int g = 0; g < 2; ++g)
#pragma unroll
        for (int pb = 0; pb < 2; ++pb)
#pragma unroll
            for (int r4 = 0; r4 < 4; ++r4) { const int c0 = (2 * g + hh) * 64 + 32 * pb + 8 * r4 + 4 * hi; const f32x4 gn = *(const f32x4*)(INF(I_GNORM) + (size_t)(l * 4 + 3) * 256 + c0);
                u32x2 w; w.x = pk2(yk[g][pb][4 * r4] * rs * gn.x, yk[g][pb][4 * r4 + 1] * rs * gn.y); w.y = pk2(yk[g][pb][4 * r4 + 2] * rs * gn.z, yk[g][pb][4 * r4 + 3] * rs * gn.w);
                *(u32x2*)(yrow + c0) = w; }
    WG_BAR();
}

__device__ __forceinline__ bf16x8 ldfrag(const LAS bf16* p) { return *(const LAS bf16x8*)p; }
__device__ __forceinline__ bf16x8 ldfrag(const bf16* p) { return *(const bf16x8*)p; }
struct NoMask { static constexpr bool ACTIVE = false; __device__ __forceinline__ bool operator()(int) const { return true; } };
template <int DK, int DV, class Mask, class PT>
__device__ __forceinline__ void flash_step(PT Kt, int ldk, PT Vt, int ldv, const bf16x8 (&qf)[DK / 16], f32x16 (&o)[DV / 32], float& mref, float& lsum, const Mask mk, int r32, int hi, bool colok = true) {
    const bool first = mref == -INFINITY; const float off = first ? 0.f : mref, noff = colok ? -off : -INFINITY;
    f32x16 s0, s1;
#pragma unroll
    for (int r = 0; r < 16; ++r) { s0[r] = noff; s1[r] = noff; }
#pragma unroll
    for (int d0 = 0; d0 < DK / 16; ++d0) {
        const bf16x8 k0 = ldfrag(Kt + r32 * ldk + 16 * d0 + 8 * hi), k1 = ldfrag(Kt + (32 + r32) * ldk + 16 * d0 + 8 * hi);
        s0 = MFMA32(k0, qf[d0], s0); s1 = MFMA32(k1, qf[d0], s1); }
    if (Mask::ACTIVE) {
#pragma unroll
        for (int r = 0; r < 16; ++r) { if (!mk(crow(r, hi))) s0[r] = -INFINITY; if (!mk(32 + crow(r, hi))) s1[r] = -INFINITY; } }
    float mx = fmaxf(s0[0], s1[0]);
#pragma unroll
    for (int r = 1; r < 16; ++r) mx = fmaxf(mx, fmaxf(s0[r], s1[r]));
    mx = fmaxf(mx, __shfl_xor(mx, 32));
    const bool need = first ? (mx > -INFINITY) : (mx > 8.0f);
    if (__any(need)) {
        const float d = need ? mx : 0.f, alpha = first ? 1.0f : __builtin_amdgcn_exp2f(-d);
        if (need) mref = off + d;
        lsum *= alpha;
#pragma unroll
        for (int db = 0; db < DV / 32; ++db) o[db] = o[db] * alpha;
#pragma unroll
        for (int r = 0; r < 16; ++r) { s0[r] -= d; s1[r] -= d; }
    }
    float ps = 0.f;
#pragma unroll
    for (int r = 0; r < 16; ++r) { s0[r] = __builtin_amdgcn_exp2f(s0[r]); s1[r] = __builtin_amdgcn_exp2f(s1[r]); ps += s0[r] + s1[r]; }
    lsum += ps;
    bf16x8 pk[4];
#pragma unroll
    for (int sp = 0; sp < 4; ++sp) { u32x4 w;
        if (sp < 2) { w.x = pk2(s0[8 * sp + 0], s0[8 * sp + 1]); w.y = pk2(s0[8 * sp + 2], s0[8 * sp + 3]); w.z = pk2(s0[8 * sp + 4], s0[8 * sp + 5]); w.w = pk2(s0[8 * sp + 6], s0[8 * sp + 7]); }
        else { const int q = sp - 2; w.x = pk2(s1[8 * q + 0], s1[8 * q + 1]); w.y = pk2(s1[8 * q + 2], s1[8 * q + 3]); w.z = pk2(s1[8 * q + 4], s1[8 * q + 5]); w.w = pk2(s1[8 * q + 6], s1[8 * q + 7]); }
        pk[sp] = __builtin_bit_cast(bf16x8, w); }
#pragma unroll
    for (int db = 0; db < DV / 32; ++db)
#pragma unroll
        for (int sp = 0; sp < 4; ++sp) { const bf16x8 a = ldfrag(Vt + (size_t)(32 * db + r32) * ldv + 16 * sp + 8 * hi); o[db] = MFMA32(a, pk[sp], o[db]); }
}

template <int DK, int DV, class Mask, class PT>
__device__ __forceinline__ void flash_step_fx(PT Kt, int ldk, PT Vt, int ldv, const bf16x8 (&qf)[DK / 16], f32x16 (&o)[DV / 32], float negref, float& lsum, const Mask mk, int r32, int hi, bool colok = true) {
    const float c0 = colok ? negref : -INFINITY;
    f32x16 s0, s1;
#ifndef REP_QK
#define REP_QK 1
#endif
    for (int rq_ = 0; rq_ < REP_QK; ++rq_) {
#pragma unroll
    for (int r = 0; r < 16; ++r) { s0[r] = c0; s1[r] = c0; }
    if (REP_QK > 1) asm volatile("" : "+v"(s0), "+v"(s1));
#pragma unroll
    for (int d0 = 0; d0 < DK / 16; ++d0) {
        const bf16x8 k0 = ldfrag(Kt + r32 * ldk + 16 * d0 + 8 * hi), k1 = ldfrag(Kt + (32 + r32) * ldk + 16 * d0 + 8 * hi);
        s0 = MFMA32(k0, qf[d0], s0); s1 = MFMA32(k1, qf[d0], s1); }
    if (REP_QK > 1) asm volatile("" : "+v"(s0), "+v"(s1)); }
    if (Mask::ACTIVE) {
#pragma unroll
        for (int r = 0; r < 16; ++r) { if (!mk(crow(r, hi))) s0[r] = -INFINITY; if (!mk(32 + crow(r, hi))) s1[r] = -INFINITY; } }
    float ps = 0.f;
#pragma unroll
    for (int r = 0; r < 16; ++r) { s0[r] = __builtin_amdgcn_exp2f(s0[r]); s1[r] = __builtin_amdgcn_exp2f(s1[r]); ps += s0[r] + s1[r]; }
    lsum += ps;
    bf16x8 pk[4];
#pragma unroll
    for (int sp = 0; sp < 4; ++sp) { u32x4 w;
        if (sp < 2) { w.x = pk2(s0[8 * sp + 0], s0[8 * sp + 1]); w.y = pk2(s0[8 * sp + 2], s0[8 * sp + 3]); w.z = pk2(s0[8 * sp + 4], s0[8 * sp + 5]); w.w = pk2(s0[8 * sp + 6], s0[8 * sp + 7]); }
        else { const int q = sp - 2; w.x = pk2(s1[8 * q + 0], s1[8 * q + 1]); w.y = pk2(s1[8 * q + 2], s1[8 * q + 3]); w.z = pk2(s1[8 * q + 4], s1[8 * q + 5]); w.w = pk2(s1[8 * q + 6], s1[8 * q + 7]); }
        pk[sp] = __builtin_bit_cast(bf16x8, w); }
#pragma unroll
    for (int sp = 0; sp < 4; ++sp)
#pragma unroll
        for (int db = 0; db < DV / 32; ++db) { const bf16x8 a = ldfrag(Vt + (size_t)(32 * db + r32) * ldv + 16 * sp + 8 * hi); o[db] = MFMA32(a, pk[sp], o[db]); }
}
template <int DK, class PT>
__device__ __forceinline__ void fx_qk(PT Kt, int ldk, const bf16x8 (&qf)[DK / 16], f32x16& s0, f32x16& s1, float c0, int r32, int hi) {
#pragma unroll
    for (int r = 0; r < 16; ++r) { s0[r] = c0; s1[r] = c0; }
#pragma unroll
    for (int d0 = 0; d0 < DK / 16; ++d0) {
        const bf16x8 k0 = ldfrag(Kt + r32 * ldk + 16 * d0 + 8 * hi), k1 = ldfrag(Kt + (32 + r32) * ldk + 16 * d0 + 8 * hi);
        s0 = MFMA32(k0, qf[d0], s0); s1 = MFMA32(k1, qf[d0], s1); }
}
template <int DV, class Mask, class PT>
__device__ __forceinline__ void fx_sv(f32x16& s0, f32x16& s1, PT Vt, int ldv, f32x16 (&o)[DV / 32], float& lsum, const Mask mk, int r32, int hi) {
    if (Mask::ACTIVE) {
#pragma unroll
        for (int r = 0; r < 16; ++r) { if (!mk(crow(r, hi))) s0[r] = -INFINITY; if (!mk(32 + crow(r, hi))) s1[r] = -INFINITY; } }
    float ps = 0.f;
#pragma unroll
    for (int r = 0; r < 16; ++r) { s0[r] = __builtin_amdgcn_exp2f(s0[r]); s1[r] = __builtin_amdgcn_exp2f(s1[r]); ps += s0[r] + s1[r]; }
    lsum += ps;
    bf16x8 pk[4];
#pragma unroll
    for (int sp = 0; sp < 4; ++sp) { u32x4 w;
        if (sp < 2) { w.x = pk2(s0[8 * sp + 0], s0[8 * sp + 1]); w.y = pk2(s0[8 * sp + 2], s0[8 * sp + 3]); w.z = pk2(s0[8 * sp + 4], s0[8 * sp + 5]); w.w = pk2(s0[8 * sp + 6], s0[8 * sp + 7]); }
        else { const int q = sp - 2; w.x = pk2(s1[8 * q + 0], s1[8 * q + 1]); w.y = pk2(s1[8 * q + 2], s1[8 * q + 3]); w.z = pk2(s1[8 * q + 4], s1[8 * q + 5]); w.w = pk2(s1[8 * q + 6], s1[8 * q + 7]); }
        pk[sp] = __builtin_bit_cast(bf16x8, w); }
#pragma unroll
    for (int sp = 0; sp < 4; ++sp)
#pragma unroll
        for (int db = 0; db < DV / 32; ++db) { const bf16x8 a = ldfrag(Vt + (size_t)(32 * db + r32) * ldv + 16 * sp + 8 * hi); o[db] = MFMA32(a, pk[sp], o[db]); }
}
template <int U>
__device__ __forceinline__ void fx_unit(f32x16& s0, f32x16& s1, unsigned (&P)[16], float& ps) {
    constexpr int b = 4 * (U & 3), nb = 4 * ((U + 1) & 3);
    const float e0 = __builtin_amdgcn_exp2f(U < 4 ? s0[b] : s1[b]), e1 = __builtin_amdgcn_exp2f(U < 4 ? s0[b + 1] : s1[b + 1]), e2 = __builtin_amdgcn_exp2f(U < 4 ? s0[b + 2] : s1[b + 2]), e3 = __builtin_amdgcn_exp2f(U < 4 ? s0[b + 3] : s1[b + 3]);
    ps += (e0 + e1) + (e2 + e3); P[2 * U] = pk2(e0, e1); P[2 * U + 1] = pk2(e2, e3);
    if (U < 7) { float n0 = U + 1 < 4 ? s0[nb] : s1[nb], n1 = U + 1 < 4 ? s0[nb + 1] : s1[nb + 1], n2 = U + 1 < 4 ? s0[nb + 2] : s1[nb + 2], n3 = U + 1 < 4 ? s0[nb + 3] : s1[nb + 3];
        asm volatile("" : "+v"(P[2 * U]), "+v"(P[2 * U + 1]), "+v"(ps), "+v"(n0), "+v"(n1), "+v"(n2), "+v"(n3));
        if (U + 1 < 4) { s0[nb] = n0; s0[nb + 1] = n1; s0[nb + 2] = n2; s0[nb + 3] = n3; } else { s1[nb] = n0; s1[nb + 1] = n1; s1[nb + 2] = n2; s1[nb + 3] = n3; } }
    else asm volatile("" : "+v"(P[2 * U]), "+v"(P[2 * U + 1]), "+v"(ps));
}
template <int NF> __device__ __forceinline__ float qnorm2(const bf16x8 (&qf)[NF]) {
    float s = 0.f;
#pragma unroll
    for (int f = 0; f < NF; ++f) { const u32x4 w = __builtin_bit_cast(u32x4, qf[f]); const unsigned ww[4] = {w.x, w.y, w.z, w.w};
#pragma unroll
        for (int j = 0; j < 4; ++j) { const float a = lo_bf(ww[j]), b = hi_bf(ww[j]); s += a * a + b * b; } }
    return s + __shfl_xor(s, 32);
}

template <int DK, class PT>
__device__ __forceinline__ void flash_qk(PT Kt, int ldk, const bf16x8 (&qf)[DK / 16], f32x16& s0, f32x16& s1, int r32, int hi) {
    s0 = f32x16{}; s1 = f32x16{};
#pragma unroll
    for (int d0 = 0; d0 < DK / 16; ++d0) {
        const bf16x8 k0 = ldfrag(Kt + r32 * ldk + 16 * d0 + 8 * hi), k1 = ldfrag(Kt + (32 + r32) * ldk + 16 * d0 + 8 * hi);
        s0 = MFMA32(k0, qf[d0], s0); s1 = MFMA32(k1, qf[d0], s1);
}
}
template <int DV, class Mask>
__device__ __forceinline__ void flash_softmax(f32x16& s0, f32x16& s1, bf16x8 (&pk)[4], f32x16 (&o)[DV / 32], float& mref, float& lsum, const Mask mk, int hi, bool colok = true) {
    if (Mask::ACTIVE) {
#pragma unroll
        for (int r = 0; r < 16; ++r) { if (!mk(crow(r, hi))) s0[r] = -INFINITY; if (!mk(32 + crow(r, hi))) s1[r] = -INFINITY; } }
    float mx = fmaxf(s0[0], s1[0]);
#pragma unroll
    for (int r = 1; r < 16; ++r) mx = fmaxf(mx, fmaxf(s0[r], s1[r]));
    mx = fmaxf(mx, __shfl_xor(mx, 32));
    if (!colok) mx = -INFINITY;
    const bool first = mref == -INFINITY;
    const bool need = first ? (mx > -INFINITY) : (mx - mref > 8.0f);
    if (__any(need)) {
        const float alpha = (need && !first) ? __builtin_amdgcn_exp2f(mref - mx) : 1.0f;
        if (need) mref = mx;
        lsum *= alpha;
#pragma unroll
        for (int db = 0; db < DV / 32; ++db) o[db] = o[db] * alpha;
    }
    const float sub = colok ? (mref == -INFINITY ? 0.f : mref) : INFINITY;
    float ps = 0.f;
#pragma unroll
    for (int r = 0; r < 16; ++r) { s0[r] = __builtin_amdgcn_exp2f(s0[r] - sub); s1[r] = __builtin_amdgcn_exp2f(s1[r] - sub); ps += s0[r] + s1[r]; }
    lsum += ps;
#pragma unroll
    for (int sp = 0; sp < 4; ++sp) { u32x4 w;
        if (sp < 2) { w.x = pk2(s0[8 * sp + 0], s0[8 * sp + 1]); w.y = pk2(s0[8 * sp + 2], s0[8 * sp + 3]); w.z = pk2(s0[8 * sp + 4], s0[8 * sp + 5]); w.w = pk2(s0[8 * sp + 6], s0[8 * sp + 7]); }
        else { const int q = sp - 2; w.x = pk2(s1[8 * q + 0], s1[8 * q + 1]); w.y = pk2(s1[8 * q + 2], s1[8 * q + 3]); w.z = pk2(s1[8 * q + 4], s1[8 * q + 5]); w.w = pk2(s1[8 * q + 6], s1[8 * q + 7]); }
        pk[sp] = __builtin_bit_cast(bf16x8, w); }
}
template <int DV, class PT>
__device__ __forceinline__ void flash_pv(const bf16x8 (&pk)[4], PT Vt, int ldv, f32x16 (&o)[DV / 32], int r32, int hi) {
#pragma unroll
    for (int db = 0; db < DV / 32; ++db)
#pragma unroll
        for (int sp = 0; sp < 4; ++sp) { const bf16x8 a = ldfrag(Vt + (size_t)(32 * db + r32) * ldv + 16 * sp + 8 * hi); o[db] = MFMA32(a, pk[sp], o[db]); }
}
template <int DV, class Mask, class PT>
__device__ __forceinline__ void flash_sv(f32x16& s0, f32x16& s1, PT Vt, int ldv, f32x16 (&o)[DV / 32], float& mref, float& lsum, const Mask mk, int r32, int hi, bool colok = true) {
    bf16x8 pk[4]; flash_softmax<DV, Mask>(s0, s1, pk, o, mref, lsum, mk, hi, colok); flash_pv<DV, PT>(pk, Vt, ldv, o, r32, hi);
}

template <class Mask>
__device__ __forceinline__ void flash_step_frag(const bf16x8 (&kf)[2][4], const bf16x8 (&vf)[2][4], const bf16x8 (&qf)[4], f32x16 (&o)[2], float& mref, float& lsum, const Mask mk, int hi) {
    const bool first = mref == -INFINITY; const float off = first ? 0.f : mref, noff = -off;
    f32x16 s0, s1;
#pragma unroll
    for (int r = 0; r < 16; ++r) { s0[r] = noff; s1[r] = noff; }
#pragma unroll
    for (int d0 = 0; d0 < 4; ++d0) { s0 = MFMA32(kf[0][d0], qf[d0], s0); s1 = MFMA32(kf[1][d0], qf[d0], s1); }
    if (Mask::ACTIVE) {
#pragma unroll
        for (int r = 0; r < 16; ++r) { if (!mk(crow(r, hi))) s0[r] = -INFINITY; if (!mk(32 + crow(r, hi))) s1[r] = -INFINITY; } }
    float mx = fmaxf(s0[0], s1[0]);
#pragma unroll
    for (int r = 1; r < 16; ++r) mx = fmaxf(mx, fmaxf(s0[r], s1[r]));
    mx = fmaxf(mx, __shfl_xor(mx, 32));
    const bool need = first ? (mx > -INFINITY) : (mx > 8.0f);
    if (__any(need)) {
        const float d = need ? mx : 0.f, alpha = first ? 1.0f : __builtin_amdgcn_exp2f(-d);
        if (need) mref = off + d;
        lsum *= alpha; o[0] = o[0] * alpha; o[1] = o[1] * alpha;
#pragma unroll
        for (int r = 0; r < 16; ++r) { s0[r] -= d; s1[r] -= d; }
    }
    float ps = 0.f;
#pragma unroll
    for (int r = 0; r < 16; ++r) { s0[r] = __builtin_amdgcn_exp2f(s0[r]); s1[r] = __builtin_amdgcn_exp2f(s1[r]); ps += s0[r] + s1[r]; }
    lsum += ps;
    bf16x8 pk[4];
#pragma unroll
    for (int sp = 0; sp < 4; ++sp) { u32x4 w;
        if (sp < 2) { w.x = pk2(s0[8 * sp + 0], s0[8 * sp + 1]); w.y = pk2(s0[8 * sp + 2], s0[8 * sp + 3]); w.z = pk2(s0[8 * sp + 4], s0[8 * sp + 5]); w.w = pk2(s0[8 * sp + 6], s0[8 * sp + 7]); }
        else { const int q = sp - 2; w.x = pk2(s1[8 * q + 0], s1[8 * q + 1]); w.y = pk2(s1[8 * q + 2], s1[8 * q + 3]); w.z = pk2(s1[8 * q + 4], s1[8 * q + 5]); w.w = pk2(s1[8 * q + 6], s1[8 * q + 7]); }
        pk[sp] = __builtin_bit_cast(bf16x8, w); }
#pragma unroll
    for (int db = 0; db < 2; ++db)
#pragma unroll
        for (int sp = 0; sp < 4; ++sp) o[db] = MFMA32(vf[db][sp], pk[sp], o[db]);
}

constexpr float MLA_QS = 0.10206207261596575f * 1.4426950408889634f;
__device__ __forceinline__ void mla_prep_tile(const Args& A, int l, int tile, LAS unsigned char* lds) {
    unsigned char* ws = A.ws;
    int tid = threadIdx.x; asm volatile("" : "+v"(tid)); const int lane = tid & 63, wid = __builtin_amdgcn_readfirstlane(tid >> 6), r32 = lane & 31, hi = lane >> 5;
    const int tok0 = tile * 64, b = tok0 / SEQ, s0 = tok0 % SEQ;
    LAS bf16* Aq = (LAS bf16*)lds; LAS bf16* Akv = (LAS bf16*)(lds + 25600);
    const bf16* U = (const bf16*)(ws + WS_U);
    bf16* Qo = (bf16*)(ws + WS_MQ); bf16* Ko = (bf16*)(ws + WS_MK); bf16* VTo = (bf16*)(ws + WS_MVT);
    const float* cosm = (const float*)(ws + WS_ROPEM); const float* sinm = cosm + SEQ * 16;
    bf16x8 wfr[2][12];
    const bf16* Wq_ = (const bf16*)(ws + WS_WUQ) + (size_t)l * 384 * 192 + (size_t)r32 * 192 + 8 * hi; const bf16* Wkv_ = (const bf16*)(ws + WS_WUKV) + (size_t)l * 512 * 128 + (size_t)r32 * 128 + 8 * hi;
#define MLAP_LDW(slot, i) do { if ((i) < 3) { const bf16* wp_ = Wq_ + (size_t)(32 * ((wid >> 1) + 4 * (i))) * 192; _Pragma("unroll") for (int ks = 0; ks < 12; ++ks) wfr[slot][ks] = *(const bf16x8*)(wp_ + 16 * ks); } \
        else { const bf16* wp_ = Wkv_ + (size_t)(32 * (4 * ((i) - 3) + (wid >> 1))) * 128; _Pragma("unroll") for (int ks = 0; ks < 8; ++ks) wfr[slot][ks] = *(const bf16x8*)(wp_ + 16 * ks); } } while (0)
    MLAP_LDW(0, 0);
#ifndef REP_PA
#define REP_PA 1
#endif
#ifndef REP_PB
#define REP_PB 1
#endif
    for (int rpa_ = 0; rpa_ < REP_PA; ++rpa_)
    {   const int tt = tid >> 3, sub = tid & 7; const bf16* ur = U + (size_t)(tok0 + tt) * INC; const int s = s0 + tt;
        u32x4 wq[3], wk[2]; f32x4 gqv[6], gkv[4];
#pragma unroll
        for (int q = 0; q < 3; ++q) wq[q] = *(const u32x4*)(ur + U_CQ + sub * 24 + 8 * q);
#pragma unroll
        for (int q = 0; q < 2; ++q) wk[q] = *(const u32x4*)(ur + U_CKV + sub * 16 + 8 * q);
        const unsigned w1 = *(const unsigned*)(ur + U_KPE + 2 * sub), w2 = *(const unsigned*)(ur + U_KPE + 16 + 2 * sub);
#pragma unroll
        for (int q = 0; q < 6; ++q) gqv[q] = *(const f32x4*)(INF(I_MLA_QN) + l * 192 + sub * 24 + 4 * q);
#pragma unroll
        for (int q = 0; q < 4; ++q) gkv[q] = *(const f32x4*)(INF(I_MLA_KVN) + l * 128 + sub * 16 + 4 * q);
        const f32x2_t cc = *(const f32x2_t*)(cosm + s * 16 + 2 * sub), nn = *(const f32x2_t*)(sinm + s * 16 + 2 * sub);
        float v[24]; float ss = 0.f;
#pragma unroll
        for (int q = 0; q < 3; ++q) { const unsigned ww[4] = {wq[q].x, wq[q].y, wq[q].z, wq[q].w};
#pragma unroll
            for (int j = 0; j < 4; ++j) { v[8 * q + 2 * j] = lo_bf(ww[j]); v[8 * q + 2 * j + 1] = hi_bf(ww[j]); } }
#pragma unroll
        for (int j = 0; j < 24; ++j) ss += v[j] * v[j];
        ss += __shfl_xor(ss, 1); ss += __shfl_xor(ss, 2); ss += __shfl_xor(ss, 4);
        float rs = __builtin_amdgcn_rsqf(ss * (1.f / 192.f) + EPS);
#pragma unroll
        for (int q = 0; q < 3; ++q) { const f32x4 g0 = gqv[2 * q], g1 = gqv[2 * q + 1]; u32x4 o; o.x = pk2(v[8 * q] * rs * g0.x, v[8 * q + 1] * rs * g0.y); o.y = pk2(v[8 * q + 2] * rs * g0.z, v[8 * q + 3] * rs * g0.w);
            o.z = pk2(v[8 * q + 4] * rs * g1.x, v[8 * q + 5] * rs * g1.y); o.w = pk2(v[8 * q + 6] * rs * g1.z, v[8 * q + 7] * rs * g1.w);
            *(LAS u32x4*)(Aq + tt * 200 + sub * 24 + 8 * q) = o; }
        ss = 0.f;
#pragma unroll
        for (int q = 0; q < 2; ++q) { const unsigned ww[4] = {wk[q].x, wk[q].y, wk[q].z, wk[q].w};
#pragma unroll
            for (int j = 0; j < 4; ++j) { v[8 * q + 2 * j] = lo_bf(ww[j]); v[8 * q + 2 * j + 1] = hi_bf(ww[j]); } }
#pragma unroll
        for (int j = 0; j < 16; ++j) ss += v[j] * v[j];
        ss += __shfl_xor(ss, 1); ss += __shfl_xor(ss, 2); ss += __shfl_xor(ss, 4);
        rs = __builtin_amdgcn_rsqf(ss * (1.f / 128.f) + EPS);
#pragma unroll
        for (int q = 0; q < 2; ++q) { const f32x4 g0 = gkv[2 * q], g1 = gkv[2 * q + 1]; u32x4 o; o.x = pk2(v[8 * q] * rs * g0.x, v[8 * q + 1] * rs * g0.y); o.y = pk2(v[8 * q + 2] * rs * g0.z, v[8 * q + 3] * rs * g0.w);
            o.z = pk2(v[8 * q + 4] * rs * g1.x, v[8 * q + 5] * rs * g1.y); o.w = pk2(v[8 * q + 6] * rs * g1.z, v[8 * q + 7] * rs * g1.w);
            *(LAS u32x4*)(Akv + tt * 136 + sub * 16 + 8 * q) = o; }
        const float c0 = cc.x, c1 = cc.y, n0 = nn.x, n1 = nn.y;
        const float a0 = lo_bf(w1), a1 = hi_bf(w1), b0 = lo_bf(w2), b1 = hi_bf(w2);
        const unsigned o1 = pk2(a0 * c0 - b0 * n0, a1 * c1 - b1 * n1), o2 = pk2(b0 * c0 + a0 * n0, b1 * c1 + a1 * n1);
        bf16* kr = Ko + (size_t)(tok0 + tt) * 384;
#pragma unroll
        for (int h = 0; h < 4; ++h) { *(unsigned*)(kr + h * 96 + 64 + 2 * sub) = o1; *(unsigned*)(kr + h * 96 + 80 + 2 * sub) = o2; }
        {   float kss = (a0 * a0 + a1 * a1) + (b0 * b0 + b1 * b1);
            kss += __shfl_xor(kss, 1); kss += __shfl_xor(kss, 2); kss += __shfl_xor(kss, 4);
            kss = fmaxf(kss, __shfl_xor(kss, 8)); kss = fmaxf(kss, __shfl_xor(kss, 16)); kss = fmaxf(kss, __shfl_xor(kss, 32));
            if (lane == 0) kmax_update((LAS unsigned*)(lds + LDS_MISC + 64), 64 + b, kss); }
    }
    WG_BAR();
    const int tb = wid & 1, tok = tok0 + 32 * tb + r32, s = s0 + 32 * tb + r32;
    {
        const int part = wid >> 1;
        for (int rpb_ = 0; rpb_ < REP_PB; ++rpb_) { if (rpb_) MLAP_LDW(0, 0);
#pragma unroll
        for (int i = 0; i < 7; ++i) {
            if (i + 1 < 7) MLAP_LDW((i + 1) & 1, i + 1);
            if (i < 3) { const int fb = (wid >> 1) + 4 * i, head = fb / 3, qpart = fb % 3; f32x16 acc = {};
#pragma unroll
                for (int ks = 0; ks < 12; ++ks) { const bf16x8 bq = *(const LAS bf16x8*)(Aq + (32 * tb + r32) * 200 + 16 * ks + 8 * hi); acc = MFMA32(wfr[i & 1][ks], bq, acc); }
                bf16* qr = Qo + (size_t)tok * 384 + head * 96;
                if (qpart < 2) {
#pragma unroll
                    for (int r4 = 0; r4 < 4; ++r4) { u32x2 w; w.x = pk2(acc[4 * r4] * MLA_QS, acc[4 * r4 + 1] * MLA_QS); w.y = pk2(acc[4 * r4 + 2] * MLA_QS, acc[4 * r4 + 3] * MLA_QS); *(u32x2*)(qr + 32 * qpart + 8 * r4 + 4 * hi) = w; }
                } else {
#pragma unroll
                    for (int r4 = 0; r4 < 2; ++r4) { float o1[4], o2[4];
#pragma unroll
                        for (int j = 0; j < 4; ++j) { const int ii = 8 * r4 + 4 * hi + j; const float c = cosm[s * 16 + ii], sn = sinm[s * 16 + ii], x1 = acc[4 * r4 + j], x2 = acc[4 * r4 + j + 8];
                            o1[j] = (x1 * c - x2 * sn) * MLA_QS; o2[j] = (x2 * c + x1 * sn) * MLA_QS; }
                        u32x2 w; w.x = pk2(o1[0], o1[1]); w.y = pk2(o1[2], o1[3]); *(u32x2*)(qr + 64 + 8 * r4 + 4 * hi) = w;
                        w.x = pk2(o2[0], o2[1]); w.y = pk2(o2[2], o2[3]); *(u32x2*)(qr + 80 + 8 * r4 + 4 * hi) = w; }
                }
            } else { const int head = i - 3; f32x16 acc = {};
#pragma unroll
                for (int ks = 0; ks < 8; ++ks) { const bf16x8 bq = *(const LAS bf16x8*)(Akv + (32 * tb + r32) * 136 + 16 * ks + 8 * hi); acc = MFMA32(wfr[i & 1][ks], bq, acc); }
                if (part < 2) { bf16* kr = Ko + (size_t)tok * 384 + head * 96 + 32 * part;
#pragma unroll
                    for (int r4 = 0; r4 < 4; ++r4) { u32x2 w; w.x = pk2(acc[4 * r4], acc[4 * r4 + 1]); w.y = pk2(acc[4 * r4 + 2], acc[4 * r4 + 3]); *(u32x2*)(kr + 8 * r4 + 4 * hi) = w; }
                    float kss = 0.f;
#pragma unroll
                    for (int r = 0; r < 16; ++r) kss += acc[r] * acc[r];
                    kss += __shfl_xor(kss, 32);
#pragma unroll
                    for (int o_ = 1; o_ < 32; o_ <<= 1) kss = fmaxf(kss, __shfl_xor(kss, o_));
                    if (lane == 0) kmax_update((LAS unsigned*)(lds + LDS_MISC + 64), (b * 4 + head) * 4 + part, kss);
                } else { bf16* vt = VTo + ((size_t)(b * 4 + head) * 64 + 32 * (part - 2)) * SEQ + perm16pos(s);
#ifndef REP_VS
#define REP_VS 1
#endif
                    for (int rv_ = 0; rv_ < REP_VS; ++rv_) {
#pragma unroll
                    for (int r = 0; r < 16; ++r) vt[(size_t)crow(r, hi) * SEQ] = (bf16)f2bf(acc[r]); } }
            }
        } }
    }
#undef MLAP_LDW
    WG_BAR();
}
struct CausalMask { static constexpr bool ACTIVE = true; int lim;
    __device__ __forceinline__ bool operator()(int k) const { return k <= lim; } };
__device__ __forceinline__ void mla_attn_unit(const Args& A, int l, int bh, int qb, LAS unsigned char* lds) {
    unsigned char* ws = A.ws;
    int tid = threadIdx.x; asm volatile("" : "+v"(tid)); const int lane = tid & 63, wid = __builtin_amdgcn_readfirstlane(tid >> 6), r32 = lane & 31, hi = lane >> 5;
    const int b = bh >> 2, h = bh & 3, q0 = qb * 256, nt = (q0 + 256) / 64;
    const bf16* Qg = (const bf16*)(ws + WS_MQ) + (size_t)(b * SEQ) * 384 + h * 96; const bf16* Kg = (const bf16*)(ws + WS_MK) + (size_t)(b * SEQ) * 384 + h * 96;
    const bf16* VTg = (const bf16*)(ws + WS_MVT) + (size_t)(b * 4 + h) * 64 * SEQ;
    constexpr int LDK = 104, LDV = 72, KB = 64 * LDK * 2, VB = 64 * LDV * 2;
    const int qrow = q0 + 32 * wid + r32;
    bf16x8 qf[6];
#pragma unroll
    for (int d0 = 0; d0 < 6; ++d0) qf[d0] = *(const bf16x8*)(Qg + (size_t)qrow * 384 + 16 * d0 + 8 * hi);
    f32x16 o[2] = {}; float ls = 0.f;
    float negref; { const float k2 = kmax_read(ws, l, (b * 4 + h) * 4, lane, (int)gridDim.x) + kmax_read(ws, l, (b * 4 + h) * 4 + 1, lane, (int)gridDim.x) + kmax_read(ws, l, 64 + b, lane, (int)gridDim.x);
        negref = -(sqrtf(qnorm2<6>(qf) * k2) * 1.02f + 0.25f); }
    const int c1 = tid < 256 ? tid + 512 : tid;
    const int kk0 = tid / 12, kc0 = tid % 12, kk1 = c1 / 12, kc1 = c1 % 12, vd = tid >> 3, vc = tid & 7;
    u32x4 ra0, ra1, rav;
#define MLA_LOAD1(R0, R1, RV, kt) do { const int kt_ = (kt) < nt ? (kt) : nt - 1; R0 = *(const u32x4*)(Kg + (size_t)(kt_ * 64 + kk0) * 384 + 8 * kc0); R1 = *(const u32x4*)(Kg + (size_t)(kt_ * 64 + kk1) * 384 + 8 * kc1); \
        RV = *(const u32x4*)(VTg + (size_t)vd * SEQ + kt_ * 64 + 8 * vc); } while (0)
#define MLA_STORE1(R0, R1, RV, buf) do { LAS unsigned char* kb_ = lds + (buf) * (KB + VB); *(LAS u32x4*)(kb_ + (kk0 * LDK + 8 * kc0) * 2) = R0; *(LAS u32x4*)(kb_ + (kk1 * LDK + 8 * kc1) * 2) = R1; \
        *(LAS u32x4*)(kb_ + KB + (vd * LDV + 8 * vc) * 2) = RV; } while (0)
#define MLA_STEP(kt, buf) do { if ((kt) <= ktmax) { const LAS bf16* Kt = (const LAS bf16*)(lds + (buf) * (KB + VB)); const LAS bf16* Vt = (const LAS bf16*)(lds + (buf) * (KB + VB) + KB); \
            if ((kt) * 64 + 63 > q0 + 32 * wid) { int hi_ = hi; asm volatile("" : "+v"(hi_));     \
                flash_step_fx<96, 64, CausalMask, const LAS bf16*>(Kt, LDK, Vt, LDV, qf, o, negref, ls, CausalMask{qrow - (kt) * 64}, r32, hi_); } \
            else flash_step_fx<96, 64, NoMask, const LAS bf16*>(Kt, LDK, Vt, LDV, qf, o, negref, ls, NoMask{}, r32, hi); } } while (0)
    const int ktmax = (q0 + 32 * wid + 31) / 64;
    MLA_LOAD1(ra0, ra1, rav, 0); MLA_STORE1(ra0, ra1, rav, 0); MLA_LOAD1(ra0, ra1, rav, 1); MLA_STORE1(ra0, ra1, rav, 1);
    WG_BAR();
    for (int kt = 0, pb = 0; kt < nt; kt += 2, pb ^= 2) {
        MLA_LOAD1(ra0, ra1, rav, kt + 2);
        if (kt + 1 < ktmax) {
            const LAS bf16* kfa = (const LAS bf16*)(lds + pb * (KB + VB)) + r32 * LDK + 8 * hi; const LAS bf16* kfb = kfa + (KB + VB) / 2;
            const LAS bf16* vfa = (const LAS bf16*)(lds + pb * (KB + VB) + KB) + r32 * LDV + 8 * hi; const LAS bf16* vfb = vfa + (KB + VB) / 2;
            f32x16 sa0, sa1, sb0, sb1, cneg; unsigned pa[16], pq[16]; float ps = 0.f;
            { float nr = negref; asm volatile("" : "+v"(nr));
#pragma unroll
              for (int r = 0; r < 16; ++r) cneg[r] = nr; }
            bf16x8 f0 = ldfrag(kfa), f1 = ldfrag(kfa + 32 * LDK), n0, n1;
#define SB() __builtin_amdgcn_sched_barrier(0)
#define FX_PK(P, sp) __builtin_bit_cast(bf16x8, (u32x4){P[4 * (sp)], P[4 * (sp) + 1], P[4 * (sp) + 2], P[4 * (sp) + 3]})
#pragma unroll
            for (int d0 = 0; d0 < 6; ++d0) {
                if (d0 < 5) { n0 = ldfrag(kfa + 16 * (d0 + 1)); n1 = ldfrag(kfa + 32 * LDK + 16 * (d0 + 1)); } else { n0 = ldfrag(kfb); n1 = ldfrag(kfb + 32 * LDK); }
                if (d0 == 0) { sa0 = MFMA32(f0, qf[0], cneg); sa1 = MFMA32(f1, qf[0], cneg); } else { sa0 = MFMA32(f0, qf[d0], sa0); sa1 = MFMA32(f1, qf[d0], sa1); }
                f0 = n0; f1 = n1; SB(); }
#pragma unroll
            for (int d0 = 0; d0 < 6; ++d0) {
                if (d0 < 5) { n0 = ldfrag(kfb + 16 * (d0 + 1)); n1 = ldfrag(kfb + 32 * LDK + 16 * (d0 + 1)); } else { n0 = ldfrag(vfa); n1 = ldfrag(vfa + 32 * LDV); }
                if (d0 == 0) sb0 = MFMA32(f0, qf[0], cneg); else sb0 = MFMA32(f0, qf[d0], sb0);
                if (d0 == 0) fx_unit<0>(sa0, sa1, pa, ps); else if (d0 == 1) fx_unit<2>(sa0, sa1, pa, ps); else if (d0 == 2) fx_unit<3>(sa0, sa1, pa, ps); else if (d0 == 3) fx_unit<4>(sa0, sa1, pa, ps); else if (d0 == 4) fx_unit<6>(sa0, sa1, pa, ps); else fx_unit<7>(sa0, sa1, pa, ps);
                SB();
                if (d0 == 0) sb1 = MFMA32(f1, qf[0], cneg); else sb1 = MFMA32(f1, qf[d0], sb1);
                if (d0 == 0) fx_unit<1>(sa0, sa1, pa, ps); else if (d0 == 3) fx_unit<5>(sa0, sa1, pa, ps);
                f0 = n0; f1 = n1; SB(); }
#pragma unroll
            for (int ix = 0; ix < 8; ++ix) {
                if (ix < 6) n0 = ldfrag(vfa + 32 * ((ix + 2) & 1) * LDV + 16 * ((ix + 2) >> 1)); else n0 = ldfrag(vfb + 32 * (ix & 1) * LDV);
                o[ix & 1] = MFMA32(f0, FX_PK(pa, ix >> 1), o[ix & 1]);
                if (ix == 0) fx_unit<0>(sb0, sb1, pq, ps); else if (ix == 1) fx_unit<1>(sb0, sb1, pq, ps); else if (ix == 2) fx_unit<2>(sb0, sb1, pq, ps); else if (ix == 3) fx_unit<3>(sb0, sb1, pq, ps); else if (ix == 4) fx_unit<4>(sb0, sb1, pq, ps); else if (ix == 5) fx_unit<5>(sb0, sb1, pq, ps); else if (ix == 6) fx_unit<6>(sb0, sb1, pq, ps); else fx_unit<7>(sb0, sb1, pq, ps);
                if (ix == 3) { MLA_STORE1(ra0, ra1, rav, pb ^ 2); MLA_LOAD1(ra0, ra1, rav, kt + 3); }
                f0 = f1; f1 = n0; SB(); }
#pragma unroll
            for (int ix = 0; ix < 8; ++ix) {
                if (ix < 6) n0 = ldfrag(vfb + 32 * ((ix + 2) & 1) * LDV + 16 * ((ix + 2) >> 1));
                o[ix & 1] = MFMA32(f0, FX_PK(pq, ix >> 1), o[ix & 1]);
                f0 = f1; f1 = n0; SB(); }
            ls += ps;
#undef FX_PK
#undef SB
        } else { MLA_STEP(kt, pb); MLA_STORE1(ra0, ra1, rav, pb ^ 2); MLA_LOAD1(ra0, ra1, rav, kt + 3); MLA_STEP(kt + 1, pb + 1); }
        MLA_STORE1(ra0, ra1, rav, (pb ^ 2) + 1);
        WG_BAR();
    }
#undef MLA_LOAD1
#undef MLA_STORE1
#undef MLA_STEP
    ls += __shfl_xor(ls, 32); const float inv = 1.0f / ls;
    bf16* yr = (bf16*)(ws + WS_MRAW) + (size_t)(b * SEQ + qrow) * 256 + h * 64;
#pragma unroll
    for (int db = 0; db < 2; ++db)
#pragma unroll
        for (int r4 = 0; r4 < 4; ++r4) { u32x2 w; w.x = pk2(o[db][4 * r4] * inv, o[db][4 * r4 + 1] * inv); w.y = pk2(o[db][4 * r4 + 2] * inv, o[db][4 * r4 + 3] * inv); *(u32x2*)(yr + 32 * db + 8 * r4 + 4 * hi) = w; }
}
__device__ __forceinline__ void group_norm_tile(const Args& A, int l, int tile, int grp) {
    unsigned char* ws = A.ws; int tid = threadIdx.x; asm volatile("" : "+v"(tid)); const int tt = tid >> 3, sub = tid & 7; const int tok = tile * 64 + tt;
    const u32x4* rp = (const u32x4*)((const bf16*)(ws + WS_MRAW) + (size_t)tok * 256 + sub * 32);
    u32x4* yp = (u32x4*)((bf16*)(ws + WS_Y) + (size_t)tok * D + grp * 256 + sub * 32); const f32x4* gn = (const f32x4*)(INF(I_GNORM) + (size_t)(l * 4 + grp) * 256 + sub * 32);
    float v[32]; float ss = 0.f;
#pragma unroll
    for (int q = 0; q < 4; ++q) { const u32x4 w = rp[q]; const unsigned ww[4] = {w.x, w.y, w.z, w.w};
#pragma unroll
        for (int j = 0; j < 4; ++j) { v[8 * q + 2 * j] = lo_bf(ww[j]); v[8 * q + 2 * j + 1] = hi_bf(ww[j]); ss += v[8 * q + 2 * j] * v[8 * q + 2 * j] + v[8 * q + 2 * j + 1] * v[8 * q + 2 * j + 1]; } }
    ss += __shfl_xor(ss, 1); ss += __shfl_xor(ss, 2); ss += __shfl_xor(ss, 4);
    const float rs = __builtin_amdgcn_rsqf(ss * (1.f / 256.f) + EPS);
#pragma unroll
    for (int q = 0; q < 4; ++q) { const f32x4 g0 = gn[2 * q], g1 = gn[2 * q + 1]; u32x4 w;
        w.x = pk2(v[8 * q] * rs * g0.x, v[8 * q + 1] * rs * g0.y); w.y = pk2(v[8 * q + 2] * rs * g0.z, v[8 * q + 3] * rs * g0.w);
        w.z = pk2(v[8 * q + 4] * rs * g1.x, v[8 * q + 5] * rs * g1.y); w.w = pk2(v[8 * q + 6] * rs * g1.z, v[8 * q + 7] * rs * g1.w); yp[q] = w; }
}

constexpr float NSA_QS = 0.125f * 1.4426950408889634f;
__device__ __forceinline__ void nsa_prep_tile(const Args& A, int l, int tile, LAS unsigned char* lds) {
    unsigned char* ws = A.ws;
    int tid = threadIdx.x; asm volatile("" : "+v"(tid)); const int lane = tid & 63, wid = __builtin_amdgcn_readfirstlane(tid >> 6);
    const int tok0 = tile * 64, b = tok0 / SEQ, s0 = tok0 % SEQ;
    LAS bf16* Kc = (LAS bf16*)lds; LAS bf16* Vc = (LAS bf16*)(lds + 11520);
    const float* cosn = (const float*)(ws + WS_ROPEN); const float* sinn = cosn + SEQ * 8;
    bf16x8 cwf[2][8];
    const bf16* Wc_ = (const bf16*)(ws + WS_WCT) + (size_t)(l * 2 + (wid & 1)) * 64 * 2048 + (size_t)(16 * (wid >> 1) + (lane & 15)) * 2048 + 8 * (lane >> 4);
#pragma unroll
    for (int j = 0; j < 8; ++j) cwf[0][j] = *(const bf16x8*)(Wc_ + 32 * j);
    {   const int tt = tid >> 3, sub = tid & 7, tok = tok0 + tt, s = s0 + tt; const bf16* ur = (const bf16*)(ws + WS_U) + (size_t)tok * INC;
        const int head = sub >> 1, half = sub & 1;
        const bool halo = s0 + 64 < SEQ; const int th = halo ? 64 + (tid >> 3 & 15) : tt; const bf16* uh = (const bf16*)(ws + WS_U) + (size_t)(tok0 + th) * INC;
        u32x4 wq[4], wkv[6], whk, whv;
#pragma unroll
        for (int q = 0; q < 4; ++q) wq[q] = *(const u32x4*)(ur + U_NQ + head * 64 + half * 32 + 8 * q);
#pragma unroll
        for (int j6 = 0; j6 < 6; ++j6) wkv[j6] = *(const u32x4*)(ur + U_NKV + j6 * 64 + 8 * sub);
        whk = *(const u32x4*)(uh + U_NKV + 8 * sub); whv = *(const u32x4*)(uh + U_NKV + 64 + 8 * sub);
        const unsigned wg_ = *(const unsigned*)(ur + U_NG + 2 * (sub < 6 ? sub : 0));
        const f32x4 c0v = *(const f32x4*)(cosn + s * 8), c1v = *(const f32x4*)(cosn + s * 8 + 4), n0v = *(const f32x4*)(sinn + s * 8), n1v = *(const f32x4*)(sinn + s * 8 + 4);
        const int sh = s0 + th; const f32x4 hc0 = *(const f32x4*)(cosn + sh * 8), hc1 = *(const f32x4*)(cosn + sh * 8 + 4), hn0 = *(const f32x4*)(sinn + sh * 8), hn1 = *(const f32x4*)(sinn + sh * 8 + 4);
        const float cs[8] = {c0v.x, c0v.y, c0v.z, c0v.w, c1v.x, c1v.y, c1v.z, c1v.w}, sn[8] = {n0v.x, n0v.y, n0v.z, n0v.w, n1v.x, n1v.y, n1v.z, n1v.w};
        {
            float v[32];
#pragma unroll
            for (int q = 0; q < 4; ++q) { const unsigned ww[4] = {wq[q].x, wq[q].y, wq[q].z, wq[q].w};
#pragma unroll
                for (int j = 0; j < 4; ++j) { v[8 * q + 2 * j] = lo_bf(ww[j]); v[8 * q + 2 * j + 1] = hi_bf(ww[j]); } }
            if (half == 0) {
#pragma unroll
                for (int i = 0; i < 8; ++i) { const float x1 = v[i], x2 = v[i + 8]; v[i] = x1 * cs[i] - x2 * sn[i]; v[i + 8] = x2 * cs[i] + x1 * sn[i]; } }
            bf16* qo = (bf16*)(ws + WS_NQ) + (size_t)tok * 256 + head * 64 + half * 32;
#pragma unroll
            for (int q = 0; q < 4; ++q) { u32x4 o; o.x = pk2(v[8 * q] * NSA_QS, v[8 * q + 1] * NSA_QS); o.y = pk2(v[8 * q + 2] * NSA_QS, v[8 * q + 3] * NSA_QS);
                o.z = pk2(v[8 * q + 4] * NSA_QS, v[8 * q + 5] * NSA_QS); o.w = pk2(v[8 * q + 6] * NSA_QS, v[8 * q + 7] * NSA_QS); *(u32x4*)(qo + 8 * q) = o; }
        }
#pragma unroll
        for (int j6 = 0; j6 < 6; ++j6) {
            const unsigned ww[4] = {wkv[j6].x, wkv[j6].y, wkv[j6].z, wkv[j6].w}; float v[8];
#pragma unroll
            for (int j = 0; j < 4; ++j) { v[2 * j] = lo_bf(ww[j]); v[2 * j + 1] = hi_bf(ww[j]); }
            if ((j6 & 1) == 0) {
#pragma unroll
                for (int i = 0; i < 8; ++i) { const float other = __shfl_xor(v[i], 1); if (sub == 0) v[i] = v[i] * cs[i] - other * sn[i]; else if (sub == 1) v[i] = v[i] * cs[i] + other * sn[i]; }
            }
            if (j6 == 2 || j6 == 4) {
                float kss = 0.f;
#pragma unroll
                for (int j = 0; j < 8; ++j) kss += v[j] * v[j];
                kss += __shfl_xor(kss, 1); kss += __shfl_xor(kss, 2); kss += __shfl_xor(kss, 4);
                kss = fmaxf(kss, __shfl_xor(kss, 8)); kss = fmaxf(kss, __shfl_xor(kss, 16)); kss = fmaxf(kss, __shfl_xor(kss, 32));
                if (lane == 0) kmax_update((LAS unsigned*)(lds + LDS_MISC + 64), (j6 == 2 ? 72 : 80) + b, kss); }
            u32x4 o; o.x = pk2(v[0], v[1]); o.y = pk2(v[2], v[3]); o.z = pk2(v[4], v[5]); o.w = pk2(v[6], v[7]);
            if (j6 == 0) *(LAS u32x4*)(Kc + tt * 72 + 8 * sub) = o;
            else if (j6 == 1) *(LAS u32x4*)(Vc + tt * 72 + 8 * sub) = o;
            else if (j6 == 2) *(u32x4*)((bf16*)(ws + WS_NKS) + (size_t)tok * 64 + 8 * sub) = o;
            else if (j6 == 4) *(u32x4*)((bf16*)(ws + WS_NKW) + (size_t)tok * 64 + 8 * sub) = o;
            else { bf16* vt = (bf16*)(ws + (j6 == 3 ? WS_NVTS : WS_NVTW)) + ((size_t)b * 64 + 8 * sub) * SEQ + perm16pos(s);
#pragma unroll
                for (int j = 0; j < 8; ++j) vt[(size_t)j * SEQ] = (bf16)f2bf(v[j]); }
        }
        if (sub < 6) { float* go = (float*)(ws + WS_NGATE) + (size_t)tok * 12 + 2 * sub; go[0] = sigmoidf_(lo_bf(wg_)); go[1] = sigmoidf_(hi_bf(wg_)); }
        {
            const float hcs[8] = {hc0.x, hc0.y, hc0.z, hc0.w, hc1.x, hc1.y, hc1.z, hc1.w}, hsn[8] = {hn0.x, hn0.y, hn0.z, hn0.w, hn1.x, hn1.y, hn1.z, hn1.w};
            const unsigned wk4[4] = {whk.x, whk.y, whk.z, whk.w}; float v[8];
#pragma unroll
            for (int j = 0; j < 4; ++j) { v[2 * j] = lo_bf(wk4[j]); v[2 * j + 1] = hi_bf(wk4[j]); }
#pragma unroll
            for (int i = 0; i < 8; ++i) { const float other = __shfl_xor(v[i], 1); if (sub == 0) v[i] = v[i] * hcs[i] - other * hsn[i]; else if (sub == 1) v[i] = v[i] * hcs[i] + other * hsn[i]; }
            if (halo && tid < 128) { u32x4 o; o.x = pk2(v[0], v[1]); o.y = pk2(v[2], v[3]); o.z = pk2(v[4], v[5]); o.w = pk2(v[6], v[7]); *(LAS u32x4*)(Kc + th * 72 + 8 * sub) = o; *(LAS u32x4*)(Vc + th * 72 + 8 * sub) = whv; }
        }
    }
    WG_BAR();
    {
        const int kv = wid & 1, ob = wid >> 1, col = lane & 15, kq = lane >> 4, nl = col & 3;
        const LAS bf16* X = kv ? Vc : Kc;
        f32x4 acc = {0.f, 0.f, 0.f, 0.f};
#pragma unroll
        for (int c8 = 0; c8 < 8; ++c8) {
            if (c8 + 1 < 8) {
#pragma unroll
                for (int j = 0; j < 8; ++j) cwf[(c8 + 1) & 1][j] = *(const bf16x8*)(Wc_ + 32 * (8 * (c8 + 1) + j)); }
#pragma unroll
            for (int j = 0; j < 8; ++j) { const int ks = 8 * c8 + j, kk = 32 * ks + 8 * kq;
                const bf16x8 bx = *(const LAS bf16x8*)(X + (16 * nl + (kk >> 6)) * 72 + (kk & 63));
                acc = MFMA16(cwf[c8 & 1][j], bx, acc); } }
        if (col < 4) { const int n = s0 / 16 + nl, o0 = 16 * ob + 4 * kq; const bool real = n < 511; const f32x4 bias = *(const f32x4*)((const float*)(ws + WS_BIASC) + (l * 2 + kv) * 64 + o0);
            const f32x4 r = real ? acc + bias : (f32x4){0.f, 0.f, 0.f, 0.f};
            if (kv == 0) { u32x2 w; w.x = pk2(r.x, r.y); w.y = pk2(r.z, r.w); *(u32x2*)((bf16*)(ws + WS_NKC) + ((size_t)b * 512 + n) * 64 + o0) = w; }
            else { bf16* vt = (bf16*)(ws + WS_NVCT) + ((size_t)b * 64 + o0) * 512 + perm16pos(n); vt[0] = (bf16)f2bf(r.x); vt[512] = (bf16)f2bf(r.y); vt[1024] = (bf16)f2bf(r.z); vt[1536] = (bf16)f2bf(r.w); } }
    }
    WG_BAR();
}
#ifndef REP_CMP
#define REP_CMP 1
#endif
#ifndef REP_SEL
#define REP_SEL 1
#endif
#ifndef REP_WIN
#define REP_WIN 1
#endif
#ifndef REP_TOPK
#define REP_TOPK 1
#endif
struct SelMask { static constexpr bool ACTIVE = true; bool sel; int lim; __device__ __forceinline__ bool operator()(int k) const { return sel && k <= lim; } };
struct WinMask { static constexpr bool ACTIVE = true; int lo, hi_; __device__ __forceinline__ bool operator()(int k) const { return k > lo && k <= hi_; } };
__device__ __forceinline__ int next_bit4(unsigned m0, unsigned m1, unsigned m2, unsigned m3, int from) {
    for (int w = from >> 5; w < 4; ++w) { unsigned m = (w == 0 ? m0 : w == 1 ? m1 : w == 2 ? m2 : m3); if (w == (from >> 5)) m &= ~0u << (from & 31); if (m) return 32 * w + __builtin_ctz(m); }
    return 128;
}
__device__ __forceinline__ float dpp_x1(float x) { return __uint_as_float((unsigned)__builtin_amdgcn_update_dpp(0, (int)__float_as_uint(x), 0xB1, 0xf, 0xf, true)); }
__device__ __forceinline__ float dpp_x2(float x) { return __uint_as_float((unsigned)__builtin_amdgcn_update_dpp(0, (int)__float_as_uint(x), 0x4E, 0xf, 0xf, true)); }
__device__ __forceinline__ float dpp_hm(float x) { return __uint_as_float((unsigned)__builtin_amdgcn_update_dpp(0, (int)__float_as_uint(x), 0x141, 0xf, 0xf, true)); }
__device__ __forceinline__ int dpp_x1(int x) { return __builtin_amdgcn_update_dpp(0, x, 0xB1, 0xf, 0xf, true); }
__device__ __forceinline__ int dpp_x2(int x) { return __builtin_amdgcn_update_dpp(0, x, 0x4E, 0xf, 0xf, true); }
__device__ __forceinline__ int dpp_hm(int x) { return __builtin_amdgcn_update_dpp(0, x, 0x141, 0xf, 0xf, true); }
__device__ __forceinline__ void nsa_unit(const Args& A, int l, int unit, LAS unsigned char* lds) {
    unsigned char* ws = A.ws;
    int tid = threadIdx.x; asm volatile("" : "+v"(tid));
    const int lane = tid & 63, wid = __builtin_amdgcn_readfirstlane(tid >> 6), r32 = lane & 31, hi = lane >> 5;
    const int b = unit >> 7, qblk = unit & 127, q0 = qblk * 64, cur = qblk;
    constexpr int LD = 72, TB = 64 * LD * 2;
    LAS float* IMP = (LAS float*)(lds + 4 * TB);
    LAS unsigned* SELM = (LAS unsigned*)(lds + 4 * TB + 32768);
    LAS unsigned* UNI = SELM + 256;
    LAS float* OUT = (LAS float*)(lds + 4 * TB + 32768 + 2048) + tid;
    const int ql = 8 * wid + (r32 >> 2), head = r32 & 3, qpos = q0 + ql; const size_t tok = (size_t)b * SEQ + qpos;
    bf16x8 qf[4];
#pragma unroll
    for (int d0 = 0; d0 < 4; ++d0) qf[d0] = *(const bf16x8*)((const bf16*)(ws + WS_NQ) + tok * 256 + head * 64 + 16 * d0 + 8 * hi);
    const float* gt = (const float*)(ws + WS_NGATE) + tok * 12 + head * 3; const float g_c = gt[0], g_s = gt[1], g_w = gt[2];
    float nref_s, nref_w; { const float q2 = qnorm2<4>(qf);
        nref_s = -(sqrtf(q2 * kmax_read(ws, l, 72 + b, lane, (int)gridDim.x)) * 1.02f + 0.25f); nref_w = -(sqrtf(q2 * kmax_read(ws, l, 80 + b, lane, (int)gridDim.x)) * 1.02f + 0.25f); }
    const int ldn = tid >> 3, ldc = tid & 7;
    u32x4 rk, rv;
#define NSA_LOAD(Kg, VTg, vstr, blk) do { rk = *(const u32x4*)((Kg) + (size_t)((blk) * 64 + ldn) * 64 + 8 * ldc); rv = *(const u32x4*)((VTg) + (size_t)ldn * (vstr) + (blk) * 64 + 8 * ldc); } while (0)
#define NSA_STORE(buf) do { *(LAS u32x4*)(lds + (buf) * 2 * TB + (ldn * LD + 8 * ldc) * 2) = rk; *(LAS u32x4*)(lds + (buf) * 2 * TB + TB + (ldn * LD + 8 * ldc) * 2) = rv; } while (0)
    {
        const int ntc = (4 * qblk + 2) / 64 + 1; const int nlim = (qpos - 31) >> 4;
        const bf16* Kcg = (const bf16*)(ws + WS_NKC) + (size_t)b * 512 * 64; const bf16* VTcg = (const bf16*)(ws + WS_NVCT) + (size_t)b * 64 * 512;
        for (int rep_ = 0; rep_ < REP_CMP; ++rep_) {
        float m = -1e30f, ls = 0.f;
        WG_BAR();
        for (int i = tid; i < 64 * 128; i += NTHR) IMP[i] = 0.f;
        for (int pass = 0; pass < 2; ++pass) {
            f32x16 oc[2] = {}; const float inv = ls > 0.f ? 1.0f / ls : 0.f; int p = 0;
            NSA_LOAD(Kcg, VTcg, 512, 0); NSA_STORE(0);
            WG_BAR();
            for (int t = 0; t < ntc; ++t) {
                NSA_LOAD(Kcg, VTcg, 512, (t + 1 < ntc ? t + 1 : t));
                const LAS bf16* Kt = (const LAS bf16*)(lds + p * 2 * TB); const LAS bf16* Vt = (const LAS bf16*)(lds + p * 2 * TB + TB);
                f32x16 s0 = {}, s1 = {};
#pragma unroll
                for (int d0 = 0; d0 < 4; ++d0) { const bf16x8 k0 = *(const LAS bf16x8*)(Kt + r32 * LD + 16 * d0 + 8 * hi), k1 = *(const LAS bf16x8*)(Kt + (32 + r32) * LD + 16 * d0 + 8 * hi);
                    s0 = MFMA32(k0, qf[d0], s0); s1 = MFMA32(k1, qf[d0], s1); }
#pragma unroll
                for (int r = 0; r < 16; ++r) { const int n = 64 * t + crow(r, hi); if (n > nlim) s0[r] = -INFINITY; if (n + 32 > nlim) s1[r] = -INFINITY; }
                if (pass == 0) {
                    float mx = fmaxf(s0[0], s1[0]);
#pragma unroll
                    for (int r = 1; r < 16; ++r) mx = fmaxf(mx, fmaxf(s0[r], s1[r]));
                    mx = fmaxf(mx, __shfl_xor(mx, 32));
                    const float mn = fmaxf(m, mx); float ps = 0.f;
#pragma unroll
                    for (int r = 0; r < 16; ++r) ps += __builtin_amdgcn_exp2f(s0[r] - mn) + __builtin_amdgcn_exp2f(s1[r] - mn);
                    ls = ls * __builtin_amdgcn_exp2f(m - mn) + ps; m = mn;
                } else {
#pragma unroll
                    for (int r = 0; r < 16; ++r) { s0[r] = __builtin_amdgcn_exp2f(s0[r] - m) * inv; s1[r] = __builtin_amdgcn_exp2f(s1[r] - m) * inv; }
#pragma unroll
                    for (int blk = 0; blk < 2; ++blk)
#pragma unroll
                        for (int g = 0; g < 4; ++g) { float e = blk ? s1[4 * g + 3] : s0[4 * g + 3]; float gs = blk ? (s1[4 * g] + s1[4 * g + 1]) + (s1[4 * g + 2] + e) : (s0[4 * g] + s0[4 * g + 1]) + (s0[4 * g + 2] + e);
                            gs += dpp_x1(gs); gs += dpp_x2(gs); e += dpp_x1(e); e += dpp_x2(e);
                            const int j = 16 * t + 8 * blk + 2 * g + hi;
                            if (head == 0) { __hip_atomic_fetch_add(&IMP[ql * 128 + j], gs, __ATOMIC_RELAXED, __HIP_MEMORY_SCOPE_WORKGROUP); if (j + 1 < 128) __hip_atomic_fetch_add(&IMP[ql * 128 + j + 1], e, __ATOMIC_RELAXED, __HIP_MEMORY_SCOPE_WORKGROUP); } }
                    bf16x8 pk[4];
#pragma unroll
                    for (int sp = 0; sp < 4; ++sp) { u32x4 w;
                        if (sp < 2) { w.x = pk2(s0[8 * sp + 0], s0[8 * sp + 1]); w.y = pk2(s0[8 * sp + 2], s0[8 * sp + 3]); w.z = pk2(s0[8 * sp + 4], s0[8 * sp + 5]); w.w = pk2(s0[8 * sp + 6], s0[8 * sp + 7]); }
                        else { const int q = sp - 2; w.x = pk2(s1[8 * q + 0], s1[8 * q + 1]); w.y = pk2(s1[8 * q + 2], s1[8 * q + 3]); w.z = pk2(s1[8 * q + 4], s1[8 * q + 5]); w.w = pk2(s1[8 * q + 6], s1[8 * q + 7]); }
                        pk[sp] = __builtin_bit_cast(bf16x8, w); }
#pragma unroll
                    for (int db = 0; db < 2; ++db)
#pragma unroll
                        for (int sp = 0; sp < 4; ++sp) { const bf16x8 a = *(const LAS bf16x8*)(Vt + (32 * db + r32) * LD + 16 * sp + 8 * hi); oc[db] = MFMA32(a, pk[sp], oc[db]); }
                }
                NSA_STORE(p ^ 1);
                WG_BAR();
                p ^= 1;
            }
            if (pass == 0) ls += __shfl_xor(ls, 32);
            else {
#pragma unroll
                for (int r = 0; r < 16; ++r) { OUT[r * NTHR] = oc[0][r] * g_c; OUT[(16 + r) * NTHR] = oc[1][r] * g_c; } }
        }
        }
    }
    {
        const int tq = tid >> 3, sub = tid & 7; unsigned mk0 = 0u, mk1 = 0u, mk2 = 0u, mk3 = 0u;
        for (int rep_ = 0; rep_ < REP_TOPK; ++rep_) { mk0 = mk1 = mk2 = mk3 = 0u; asm volatile("" : "+v"(mk0));
#define NSA_SETBIT(jj) do { const int j_ = (jj); const unsigned bit_ = 1u << (j_ & 31); const int w_ = j_ >> 5; mk0 |= (w_ == 0) ? bit_ : 0u; mk1 |= (w_ == 1) ? bit_ : 0u; mk2 |= (w_ == 2) ? bit_ : 0u; mk3 |= (w_ == 3) ? bit_ : 0u; } while (0)
        if (cur < 16) { for (int j = 0; j <= cur; ++j) NSA_SETBIT(j); }
        else {
            NSA_SETBIT(0); NSA_SETBIT(cur); NSA_SETBIT(cur - 1);
            float v[16];
#pragma unroll
            for (int i = 0; i < 16; ++i) { const int j = sub * 16 + i; v[i] = (j <= cur && j != 0 && j != cur && j != cur - 1) ? IMP[tq * 128 + j] : -INFINITY; }
            for (int round = 0; round < 13; ++round) {
                float bv = v[0]; int bj = sub * 16;
#pragma unroll
                for (int i = 1; i < 16; ++i) if (v[i] > bv) { bv = v[i]; bj = sub * 16 + i; }
#pragma unroll
                for (int o = 0; o < 3; ++o) { const float ov = o == 0 ? dpp_x1(bv) : o == 1 ? dpp_x2(bv) : dpp_hm(bv); const int oj = o == 0 ? dpp_x1(bj) : o == 1 ? dpp_x2(bj) : dpp_hm(bj);
                    if (ov > bv || (ov == bv && oj < bj)) { bv = ov; bj = oj; } }
                NSA_SETBIT(bj);
#pragma unroll
                for (int i = 0; i < 16; ++i) if (bj == sub * 16 + i) v[i] = -INFINITY;
            }
        }
        }
#undef NSA_SETBIT
        if (sub == 0) { SELM[tq * 4 + 0] = mk0; SELM[tq * 4 + 1] = mk1; SELM[tq * 4 + 2] = mk2; SELM[tq * 4 + 3] = mk3; }
        WG_BAR();
    }
    const bf16* Ks = (const bf16*)(ws + WS_NKS) + (size_t)(b * SEQ) * 64; const bf16* VTs = (const bf16*)(ws + WS_NVTS) + (size_t)(b * 64) * SEQ;
    const bf16* Kw = (const bf16*)(ws + WS_NKW) + (size_t)(b * SEQ) * 64; const bf16* VTw = (const bf16*)(ws + WS_NVTW) + (size_t)(b * 64) * SEQ;
    {
        const unsigned sq0 = SELM[ql * 4], sq1 = SELM[ql * 4 + 1], sq2 = SELM[ql * 4 + 2], sq3 = SELM[ql * 4 + 3];
        unsigned w0 = sq0, w1 = sq1, w2 = sq2, w3 = sq3;
#pragma unroll
        for (int o_ = 4; o_ < 64; o_ <<= 1) { w0 |= __shfl_xor(w0, o_); w1 |= __shfl_xor(w1, o_); w2 |= __shfl_xor(w2, o_); w3 |= __shfl_xor(w3, o_); }
        const unsigned u0 = __builtin_amdgcn_readfirstlane(w0), u1 = __builtin_amdgcn_readfirstlane(w1), u2 = __builtin_amdgcn_readfirstlane(w2), u3 = __builtin_amdgcn_readfirstlane(w3);
        f32x16 o[2] = {}; float ls = 0.f;
        for (int rep_ = 0; rep_ < REP_SEL; ++rep_) { o[0] = f32x16{}; o[1] = f32x16{}; ls = 0.f; asm volatile("" : "+v"(ls));
        u32x4 rka, rva, rkb, rvb;
#define SEL_LOAD(RK, RV, blk) do { const int b_ = (blk) <= cur ? (blk) : cur; RK = *(const u32x4*)(Ks + (size_t)(b_ * 64 + ldn) * 64 + 8 * ldc); RV = *(const u32x4*)(VTs + (size_t)ldn * SEQ + b_ * 64 + 8 * ldc); } while (0)
#define SEL_STORE(RK, RV, buf) do { *(LAS u32x4*)(lds + (buf) * 2 * TB + (ldn * LD + 8 * ldc) * 2) = RK; *(LAS u32x4*)(lds + (buf) * 2 * TB + TB + (ldn * LD + 8 * ldc) * 2) = RV; } while (0)
#define SEL_STEP(j, buf) do { const unsigned uw_ = ((j) >> 5) == 0 ? u0 : ((j) >> 5) == 1 ? u1 : ((j) >> 5) == 2 ? u2 : u3; \
            if ((uw_ >> ((j) & 31)) & 1u) { const unsigned sw_ = ((j) >> 5) == 0 ? sq0 : ((j) >> 5) == 1 ? sq1 : ((j) >> 5) == 2 ? sq2 : sq3; const bool sel_ = (sw_ >> ((j) & 31)) & 1u; \
                if ((j) == cur) flash_step_fx<64, 64, SelMask, const LAS bf16*>((const LAS bf16*)(lds + (buf) * 2 * TB), LD, (const LAS bf16*)(lds + (buf) * 2 * TB + TB), LD, qf, o, nref_s, ls, SelMask{sel_, ql}, r32, hi); \
                else flash_step_fx<64, 64, NoMask, const LAS bf16*>((const LAS bf16*)(lds + (buf) * 2 * TB), LD, (const LAS bf16*)(lds + (buf) * 2 * TB + TB), LD, qf, o, nref_s, ls, NoMask{}, r32, hi, sel_); } } while (0)
        SEL_LOAD(rka, rva, 0); SEL_STORE(rka, rva, 0);
        SEL_LOAD(rkb, rvb, 1);
        WG_BAR();
        for (int j = 0; j <= cur; j += 2) {
            SEL_LOAD(rka, rva, j + 2);
            SEL_STEP(j, 0);
            SEL_STORE(rkb, rvb, 1);
            WG_BAR();
            if (j + 1 > cur) break;
            SEL_LOAD(rkb, rvb, j + 3);
            SEL_STEP(j + 1, 1);
            SEL_STORE(rka, rva, 0);
            WG_BAR();
        }
#undef SEL_LOAD
#undef SEL_STORE
#undef SEL_STEP
        }
        ls += __shfl_xor(ls, 32); const float sc = g_s / ls;
#pragma unroll
        for (int r = 0; r < 16; ++r) { OUT[r * NTHR] += o[0][r] * sc; OUT[(16 + r) * NTHR] += o[1][r] * sc; }
    }
    WG_BAR();
    f32x16 tot[2];
    {
        f32x16 o[2] = {}; float ls = 0.f;
        const int kt0 = qblk >= 8 ? qblk - 8 : 0; int p = 0;
        for (int rep_ = 0; rep_ < REP_WIN; ++rep_) { o[0] = f32x16{}; o[1] = f32x16{}; ls = 0.f; p = 0; asm volatile("" : "+v"(ls));
        NSA_LOAD(Kw, VTw, SEQ, kt0); NSA_STORE(0);
        WG_BAR();
        for (int kt = kt0; kt <= qblk; ++kt) {
            NSA_LOAD(Kw, VTw, SEQ, (kt < qblk ? kt + 1 : qblk));
            const LAS bf16* Kt = (const LAS bf16*)(lds + p * 2 * TB); const LAS bf16* Vt = (const LAS bf16*)(lds + p * 2 * TB + TB);
            if (kt == qblk) flash_step_fx<64, 64, WinMask, const LAS bf16*>(Kt, LD, Vt, LD, qf, o, nref_w, ls, WinMask{-1, ql}, r32, hi);
            else if (kt == qblk - 8) flash_step_fx<64, 64, WinMask, const LAS bf16*>(Kt, LD, Vt, LD, qf, o, nref_w, ls, WinMask{ql, 63}, r32, hi);
            else flash_step_fx<64, 64, NoMask, const LAS bf16*>(Kt, LD, Vt, LD, qf, o, nref_w, ls, NoMask{}, r32, hi);
            NSA_STORE(p ^ 1);
            WG_BAR();
            p ^= 1;
        } }
        ls += __shfl_xor(ls, 32); const float sc = g_w / ls;
#pragma unroll
        for (int r = 0; r < 16; ++r) { tot[0][r] = OUT[r * NTHR] + o[0][r] * sc; tot[1][r] = OUT[(16 + r) * NTHR] + o[1][r] * sc; }
    }
#undef NSA_LOAD
#undef NSA_STORE
    {
        float ss = 0.f;
#pragma unroll
        for (int r = 0; r < 16; ++r) ss += tot[0][r] * tot[0][r] + tot[1][r] * tot[1][r];
        ss += __shfl_xor(ss, 1); ss += __shfl_xor(ss, 2); ss += __shfl_xor(ss, 32);
        const float rs = __builtin_amdgcn_rsqf(ss * (1.f / 256.f) + EPS);
        bf16* yr = (bf16*)(ws + WS_Y) + tok * D + 256 + head * 64; const float* gn = INF(I_GNORM) + (size_t)(l * 4 + 1) * 256 + head * 64;
#pragma unroll
        for (int db = 0; db < 2; ++db)
#pragma unroll
            for (int r4 = 0; r4 < 4; ++r4) { const int d = 32 * db + 8 * r4 + 4 * hi; const f32x4 g4 = *(const f32x4*)(gn + d);
                u32x2 w; w.x = pk2(tot[db][4 * r4] * rs * g4.x, tot[db][4 * r4 + 1] * rs * g4.y); w.y = pk2(tot[db][4 * r4 + 2] * rs * g4.z, tot[db][4 * r4 + 3] * rs * g4.w);
                *(u32x2*)(yr + d) = w; }
    }
    WG_BAR();
}

constexpr size_t WS_MWGU = WS_ARENA;
constexpr size_t WS_MWD = 100 * MiB;
constexpr size_t WS_HPERM = 130 * MiB;
constexpr size_t WS_MACT = 198 * MiB;
constexpr size_t WS_Y1 = 318 * MiB;
constexpr size_t WS_PARKB = 450 * MiB;
constexpr size_t WS_TOKINFO = 454 * MiB;
constexpr size_t WS_ROWTOK = 455 * MiB;
constexpr size_t WS_ROWW = WS_ROWTOK + 512 * 1024;
constexpr size_t WS_POS1 = 456 * MiB;
constexpr size_t WS_TILEE = WS_POS1 + 256 * 1024;
constexpr int MAXROWS = 67584, CW_MOE = 12288;
static_assert(WS_MWGU + (size_t)8 * 2 * DFF * D <= WS_MWD && WS_MWD + (size_t)8 * D * DFF <= WS_HPERM && WS_HPERM + (size_t)MAXROWS * D <= WS_MACT && WS_MACT + (size_t)34816 * DFF <= WS_Y1 && WS_Y1 + (size_t)MAXROWS * D * 2 <= WS_PARKB && WS_TILEE + 4096 <= WS_END, "moe map");

namespace pg8 {
struct MoeOrder : StaticOrder { const int* tile_e; int tile0; size_t estride;
    __device__ __forceinline__ size_t bofs(const Unit& u) const { return (size_t)tile_e[tile0 + u.pm] * estride; } };
struct TailOrder { const int* tile_e; int tile0, ntl, G, c; size_t estride;
    __device__ __forceinline__ bool next(int i, Unit& u) const { const long L = (long)i * G + c; if (L >= (long)ntl * 8) return false; u.pm = (int)(L >> 3); u.pn = (int)(L >> 1) & 3; u.ks = (int)L & 1; return true; }
    __device__ __forceinline__ void a_ready(const Unit&) const {}
    __device__ __forceinline__ void done(const Unit&) const {}
    __device__ __forceinline__ size_t bofs(const Unit& u) const { return (size_t)tile_e[tile0 + u.pm] * estride; } };
struct EpiMoeDown {
    static constexpr bool PERM = false, AFTER_DRAIN = false, IDEM = false;
    const int* rowtok; const float* roww; bf16_t* parkb; bf16_t* hperm; int row0g; float scale;
    __device__ __forceinline__ void operator()(const f32x4 (&acc)[2][2][4][2], const Unit& u, int wr, int wc, int fr, int fq) const {
        const int col0 = u.pn * BM + wc * 32 + 4 * fq;
#pragma unroll
        for (int ai = 0; ai < 2; ++ai)
#pragma unroll
            for (int m = 0; m < 4; ++m) { const int grow = row0g + u.pm * BM + ai * HALF + wr * 64 + m * 16 + fr; const int ti = rowtok[grow]; const float w = roww[grow] * scale;
                if (ti >= 0) { bf16_t* rp = (u.ks ? parkb + (size_t)(grow - 65536) * 1024 : hperm + (size_t)grow * 1024) + col0;
#pragma unroll
                    for (int bj = 0; bj < 2; ++bj)
#pragma unroll
                        for (int n = 0; n < 2; ++n) { const f32x4 v = acc[ai][bj][m][n] * w; u32x2 o; o.x = cvt_pk_bf16(v[0], v[1]); o.y = cvt_pk_bf16(v[2], v[3]); *(u32x2*)(rp + bj * HALF + n * 16) = o; } } }
    }
};
}

__device__ __forceinline__ void moe_router_rows(const Args& A, LAS unsigned char* lds, int gw, int ngw, int wave, int lane) {
    unsigned char* ws = A.ws; const float* X = A.out; const float* g = INF(I_NORM_FFN) + D; const float* R = INF(I_MOE_R); unsigned* cnt = (unsigned*)(ws + WS_CTL) + CW_MOE;
    LAS unsigned* lcnt = (LAS unsigned*)lds;
    LAS int* rinfo = (LAS int*)(lds + 64);
    if (threadIdx.x < 16) lcnt[threadIdx.x] = 0u;
    __syncthreads();
    int slot = 0;
    f32x4 gr_[4][4][2];
#pragma unroll
    for (int j = 0; j < 4; ++j) { const f32x4 gg = ((const f32x4*)g + lane)[64 * j]; const float gv[4] = {gg.x, gg.y, gg.z, gg.w};
#pragma unroll
        for (int i = 0; i < 4; ++i) { const f32x4* rr = (const f32x4*)(R + (size_t)(256 * j + 4 * lane + i) * 8); gr_[j][i][0] = rr[0] * gv[i]; gr_[j][i][1] = rr[1] * gv[i]; } }
    const bool b0 = lane & 1, b1 = lane & 2, b2 = lane & 4;
    for (int m = gw; m < T; m += ngw, ++slot) {
        const f32x4* xr = (const f32x4*)(X + (size_t)m * D) + lane;
        f32x4 v[4]; float s = 0.f;
#pragma unroll
        for (int j = 0; j < 4; ++j) { v[j] = xr[64 * j]; s += (v[j].x * v[j].x + v[j].y * v[j].y) + (v[j].z * v[j].z + v[j].w * v[j].w); }
        float lg[8] = {0.f, 0.f, 0.f, 0.f, 0.f, 0.f, 0.f, 0.f};
#pragma unroll
        for (int j = 0; j < 4; ++j) { const float hh[4] = {v[j].x, v[j].y, v[j].z, v[j].w};
#pragma unroll
            for (int i = 0; i < 4; ++i) { const f32x4 r0 = gr_[j][i][0], r1 = gr_[j][i][1];
                lg[0] += hh[i] * r0.x; lg[1] += hh[i] * r0.y; lg[2] += hh[i] * r0.z; lg[3] += hh[i] * r0.w; lg[4] += hh[i] * r1.x; lg[5] += hh[i] * r1.y; lg[6] += hh[i] * r1.z; lg[7] += hh[i] * r1.w; } }
        const float rs = __builtin_amdgcn_rsqf(wave_sum(s) * (1.f / D) + EPS);
        float a4[4], c2[2], d1;
#pragma unroll
        for (int k = 0; k < 4; ++k) { const float snd = b0 ? lg[k] : lg[4 + k], kp = b0 ? lg[4 + k] : lg[k]; a4[k] = kp + __shfl_xor(snd, 1); }
#pragma unroll
        for (int k = 0; k < 2; ++k) { const float snd = b1 ? a4[k] : a4[2 + k], kp = b1 ? a4[2 + k] : a4[k]; c2[k] = kp + __shfl_xor(snd, 2); }
        { const float snd = b2 ? c2[0] : c2[1], kp = b2 ? c2[1] : c2[0]; d1 = kp + __shfl_xor(snd, 4); }
        d1 += __shfl_xor(d1, 8); d1 += __shfl_xor(d1, 16); d1 += __shfl_xor(d1, 32);
        d1 *= rs;
        { const int di = (int)__float_as_uint(d1);
          lg[0] = __uint_as_float((unsigned)__builtin_amdgcn_readlane(di, 0)); lg[1] = __uint_as_float((unsigned)__builtin_amdgcn_readlane(di, 4)); lg[2] = __uint_as_float((unsigned)__builtin_amdgcn_readlane(di, 2)); lg[3] = __uint_as_float((unsigned)__builtin_amdgcn_readlane(di, 6));
          lg[4] = __uint_as_float((unsigned)__builtin_amdgcn_readlane(di, 1)); lg[5] = __uint_as_float((unsigned)__builtin_amdgcn_readlane(di, 5)); lg[6] = __uint_as_float((unsigned)__builtin_amdgcn_readlane(di, 3)); lg[7] = __uint_as_float((unsigned)__builtin_amdgcn_readlane(di, 7)); }
        int e1 = 0; float v1 = lg[0];
#pragma unroll
        for (int e = 1; e < 8; ++e) if (lg[e] > v1) { v1 = lg[e]; e1 = e; }
        int e2 = -1; float v2 = -INFINITY;
#pragma unroll
        for (int e = 0; e < 8; ++e) if (e != e1 && lg[e] > v2) { v2 = lg[e]; e2 = e; }
        if (lane == 0) { const float w1 = 1.0f / (1.0f + __expf(v2 - v1));
            const int r1 = (int)__hip_atomic_fetch_add(lcnt + e1, 1u, __ATOMIC_RELAXED, __HIP_MEMORY_SCOPE_WORKGROUP), r2 = (int)__hip_atomic_fetch_add(lcnt + e2, 1u, __ATOMIC_RELAXED, __HIP_MEMORY_SCOPE_WORKGROUP);
            LAS int* ri = rinfo + (wave * 32 + slot) * 5; ri[0] = e1; ri[1] = e2; ri[2] = r1; ri[3] = r2; ri[4] = (int)__float_as_uint(w1); }
    }
    __syncthreads();
    if (threadIdx.x < 8) lcnt[8 + threadIdx.x] = atomicAdd(&cnt[threadIdx.x], lcnt[threadIdx.x]);
    __syncthreads();
    if (lane == 0) { slot = 0;
        for (int m = gw; m < T; m += ngw, ++slot) { const LAS int* ri = rinfo + (wave * 32 + slot) * 5; const int e1 = ri[0], e2 = ri[1]; const float w1 = __uint_as_float((unsigned)ri[4]);
            int* ti = (int*)(ws + WS_TOKINFO) + (size_t)m * 8; ti[0] = e1; ti[1] = e2; ti[2] = (int)lcnt[8 + e1] + ri[2]; ti[3] = (int)lcnt[8 + e2] + ri[3]; ((float*)ti)[4] = w1; ((float*)ti)[5] = 1.0f - w1; } }
    __syncthreads();
}
__device__ __forceinline__ void moe_permute_rows(const Args& A, int gw, int ngw, int lane) {
    unsigned char* ws = A.ws; const float* X = A.out; const float* g = INF(I_NORM_FFN) + D; const unsigned* cnt = (const unsigned*)(ws + WS_CTL) + CW_MOE;
    int off[9]; off[0] = 0;
#pragma unroll
    for (int e = 0; e < 8; ++e) { const int c = (int)cnt[e]; off[e + 1] = off[e] + ((c + 255) & ~255); }
    int* rowtok = (int*)(ws + WS_ROWTOK); float* roww = (float*)(ws + WS_ROWW); int* pos1 = (int*)(ws + WS_POS1); unsigned char* hp = ws + WS_HPERM;
    if (gw == 0) {
        int* te = (int*)(ws + WS_TILEE); const int ntile = off[8] >> 8;
        for (int t = lane; t < ntile; t += 64) { int e = 0;
#pragma unroll
            for (int k = 1; k < 8; ++k) if (t * 256 >= off[k]) e = k;
            te[t] = e; }
        if (lane == 0) te[511] = ntile;
#pragma unroll
        for (int e = 0; e < 8; ++e) { const int c = (int)cnt[e]; for (int r = off[e] + c + lane; r < off[e + 1]; r += 64) rowtok[r] = -1; }
    }
    for (int m = gw; m < T; m += ngw) {
        const int* ti = (const int*)(ws + WS_TOKINFO) + (size_t)m * 8; const int e1 = ti[0], e2 = ti[1], r1 = ti[2], r2 = ti[3]; const float w1 = ((const float*)ti)[4], w2 = ((const float*)ti)[5];
        int p1 = 0, p2 = 0;
#pragma unroll
        for (int e = 0; e < 8; ++e) { if (e == e1) p1 = off[e] + r1; if (e == e2) p2 = off[e] + r2; }
        const f32x4* xr = (const f32x4*)(X + (size_t)m * D) + lane; const f32x4* gr = (const f32x4*)g + lane;
        f32x4 v[4]; float s = 0.f;
#pragma unroll
        for (int j = 0; j < 4; ++j) { v[j] = xr[64 * j]; s += (v[j].x * v[j].x + v[j].y * v[j].y) + (v[j].z * v[j].z + v[j].w * v[j].w); }
        const float rs = F8_H / sqrtf(wave_sum(s) * (1.f / D) + EPS);
        unsigned* o1 = (unsigned*)(hp + (size_t)p1 * D) + lane; unsigned* o2 = (unsigned*)(hp + (size_t)p2 * D) + lane;
#pragma unroll
        for (int j = 0; j < 4; ++j) { const f32x4 gg = gr[64 * j];
            const unsigned w = pk4_fp8(clamp8(v[j].x * rs * gg.x), clamp8(v[j].y * rs * gg.y), clamp8(v[j].z * rs * gg.z), clamp8(v[j].w * rs * gg.w));
            o1[64 * j] = w; o2[64 * j] = w; }
        if (lane == 0) { rowtok[p1] = m; roww[p1] = w1; rowtok[p2] = m | (1 << 30); roww[p2] = w2; pos1[2 * m] = p1; pos1[2 * m + 1] = p2; }
    }
}
__device__ __forceinline__ void phase_final_norm_moe(const Args& A, int gw, int ngw, int lane) {
    unsigned char* ws = A.ws; float* X = A.out; const float* g = INF(I_NORM_FINAL); const int* pos1 = (const int*)(ws + WS_POS1); const bf16* hp = (const bf16*)(ws + WS_Y1);
    for (int m = gw; m < T; m += ngw) {
        f32x4* xr = (f32x4*)(X + (size_t)m * D) + lane; const f32x4* gr = (const f32x4*)g + lane;
        const int pa = pos1[2 * m], pb = pos1[2 * m + 1]; const bf16* pbk = (const bf16*)(ws + WS_PARKB);
        const u32x2* ya = (const u32x2*)(hp + (size_t)pa * D) + lane; const u32x2* yb = (const u32x2*)(hp + (size_t)pb * D) + lane;
        f32x4 v[4]; float s = 0.f;
#pragma unroll
        for (int j = 0; j < 4; ++j) { const u32x2 y = ya[64 * j], z = yb[64 * j]; v[j] = xr[64 * j]; v[j].x += lo_bf(y.x) + lo_bf(z.x); v[j].y += hi_bf(y.x) + hi_bf(z.x); v[j].z += lo_bf(y.y) + lo_bf(z.y); v[j].w += hi_bf(y.y) + hi_bf(z.y); }
        if (pa >= 65536) { const u32x2* yc = (const u32x2*)(pbk + (size_t)(pa - 65536) * D) + lane;
#pragma unroll
            for (int j = 0; j < 4; ++j) { const u32x2 y = yc[64 * j]; v[j].x += lo_bf(y.x); v[j].y += hi_bf(y.x); v[j].z += lo_bf(y.y); v[j].w += hi_bf(y.y); } }
        if (pb >= 65536) { const u32x2* yc = (const u32x2*)(pbk + (size_t)(pb - 65536) * D) + lane;
#pragma unroll
            for (int j = 0; j < 4; ++j) { const u32x2 y = yc[64 * j]; v[j].x += lo_bf(y.x); v[j].y += hi_bf(y.x); v[j].z += lo_bf(y.y); v[j].w += hi_bf(y.y); } }
#pragma unroll
        for (int j = 0; j < 4; ++j) s += (v[j].x * v[j].x + v[j].y * v[j].y) + (v[j].z * v[j].z + v[j].w * v[j].w);
        const float rs = __builtin_amdgcn_rsqf(wave_sum(s) * (1.f / D) + EPS);
#pragma unroll
        for (int j = 0; j < 4; ++j) xr[64 * j] = v[j] * rs * gr[64 * j];
    }
}
__device__ __forceinline__ void moe_prep_weights(const Args& A, LAS unsigned char* lds, int gw, int ngw, int wave, int lane) {
    unsigned char* ws = A.ws; LAS float* scr = (LAS float*)(lds + wave * 16384);
    for (int e = 0; e < NEXP; ++e) {
        const float* wg = INF(I_MOE_WG) + (size_t)e * D * DFF; const float* wu = INF(I_MOE_WU) + (size_t)e * D * DFF;
        transpose_matrix8(SrcMap{wg, (long long)(wu - wg), 2, DFF}, DFF, D, 2 * DFF, ws + WS_MWGU + (size_t)e * 2 * DFF * D, F8_WGU, scr, gw, ngw, lane);
        transpose_matrix8(SrcMap{INF(I_MOE_WD) + (size_t)e * DFF * D, 0, 0, D}, D, DFF, D, ws + WS_MWD + (size_t)e * D * DFF, F8_WD, scr, gw, ngw, lane, 1);
    }
}

#ifndef MK_MULTI
#define MK_MULTI 0
#endif
#ifndef HAVE_MOE
#define HAVE_MOE 1
#endif
#ifndef DUP_PREP
#define DUP_PREP 1
#endif
#ifndef DUP_ATTN
#define DUP_ATTN 1
#endif
#ifndef DUP_MLA
#define DUP_MLA 1
#endif
#ifndef DUP_NSA
#define DUP_NSA 1
#endif
#ifndef DUP_GEMM
#define DUP_GEMM 1
#endif
#ifndef DUP_P0
#define DUP_P0 1
#endif
#ifndef DUP_MOEW
#define DUP_MOEW 1
#endif
#ifndef DUP_NORM
#define DUP_NORM 1
#endif
#ifndef DUP_FIN
#define DUP_FIN 1
#endif
constexpr int N_PHASES = HAVE_MOE ? 22 : 16;

#define IN(k) (lo <= (k) && (k) < hi)
#define SEAM(k) do { if ((k) + 1 < hi) xcd_barrier(bar); } while (0)
template <int L> __device__ __forceinline__ void mixer_phases(const Args& A, LAS unsigned char* lds, const XcdBarrier& bar, int lo, int hi, int G) {
    unsigned char* ws = A.ws; (void)ws;
        constexpr int pb = 1 + 9 * L;
        if (IN(pb + 0)) { constexpr int ll = L;
#if INPROJ_F8
            pg8::Gemm g{(const pg8::bf16_t*)(ws + WS_HN), (const pg8::bf16_t*)(ws + WS_WIN + (size_t)ll * INC * D), T, INC, D / 2, 0};
            pg8::StaticOrder S; S.init(T, INC, G, (int)blockIdx.x);
            pg8::EpiBf16S E{(pg8::bf16_t*)(ws + WS_U), INC, 1.0f / (F8_H * F8_WGU)};
            pg8::gemm_phase<pg8::EpiBf16S, pg8::StaticOrder, true, true, true>(lds, g, S, E);
#else
            pg8::Gemm g{(const pg8::bf16_t*)(ws + WS_HN), (const pg8::bf16_t*)(ws + WS_WIN) + (size_t)ll * INC * D, T, INC, D, 0};
            pg8::StaticOrder S; S.init(T, INC, G, (int)blockIdx.x);
            pg8::EpiBf16<0> E{(pg8::bf16_t*)(ws + WS_U), INC, nullptr, 0, 0, 1.f};
            pg8::gemm_phase<pg8::EpiBf16<0>, pg8::StaticOrder, true, true>(lds, g, S, E);
#endif
            SEAM(pb + 0);
        }
        if (IN(pb + 1)) { constexpr int ll = L;
            if (threadIdx.x < KM_WORDS) ((LAS unsigned*)(lds + LDS_MISC + 64))[threadIdx.x] = 0u;
            __syncthreads();
            for (int rep = 0; rep < DUP_PREP; ++rep) {
#ifndef RP_LRU
#define RP_LRU 1
#endif
#ifndef RP_MLA
#define RP_MLA 1
#endif
#ifndef RP_NSA
#define RP_NSA 1
#endif
#ifndef RP_SSD
#define RP_SSD 1
#endif
            for (int tile = blockIdx.x; tile < T / 64; tile += G) { for (int r_ = 0; r_ < RP_LRU; ++r_) lru_local_tile(A, ll, tile, lds); for (int r_ = 0; r_ < RP_MLA; ++r_) mla_prep_tile(A, ll, tile, lds); for (int r_ = 0; r_ < RP_NSA; ++r_) nsa_prep_tile(A, ll, tile, lds); }
            for (int r_ = 0; r_ < RP_SSD; ++r_) for (int u = blockIdx.x; u < NB * 64 * 2; u += G) ssd_state_unit(A, ll, u, lds); }
            __syncthreads();
            if (threadIdx.x < KM_WORDS) ((unsigned*)(ws + WS_CTL) + CW_KMG)[(size_t)(ll * KM_WORDS + threadIdx.x) * 256 + (blockIdx.x & 255)] = ((LAS unsigned*)(lds + LDS_MISC + 64))[threadIdx.x];
            SEAM(pb + 1);
        }
        if (IN(pb + 2)) { constexpr int ll = L;
            unsigned* qctr = (unsigned*)(ws + WS_CTL) + CW_Q + 128 * L; volatile LAS unsigned* slot = (volatile LAS unsigned*)(lds + LDS_MISC) + 4;
#ifndef REP_MLA
#define REP_MLA 1
#endif
#ifndef STATIC_ATTN
#define STATIC_ATTN 0
#endif
            int steal = 0;
            for (int it_ = 0;; ++it_) {
                __syncthreads();
                if (threadIdx.x == 0) { unsigned code = ~0u;
                    while (steal < (STATIC_ATTN ? 1 : 8)) { const int g = (int)((blockIdx.x + steal) & 7), nw = (G - g + 7) >> 3;
                        const unsigned pos = STATIC_ATTN ? (unsigned)((blockIdx.x >> 3) + it_ * nw) : (it_ == 0 && steal == 0 ? (unsigned)(blockIdx.x >> 3) : atomicAdd(qctr + 16 * g, 1u) + (unsigned)nw);
                        if (pos < 137u) { code = (unsigned)g * 256u + pos; break; }
                        ++steal; }
                    *slot = code; }
                __syncthreads();
                const unsigned code = *slot;
                if (code == ~0u) break;
                const int g = (int)(code >> 8), pos = (int)(code & 255);
                if (pos < 32 || (pos >= 41 && pos < 73)) { const int j = pos < 32 ? pos : pos - 9; for (int r_ = 0; r_ < REP_MLA; ++r_) mla_attn_unit(A, ll, g + 8 * (j & 1), 31 - (j >> 1), lds); }
                else if (pos < 40) ssd_prop_unit(A, (pos - 32) * 8 + g);
                else if (pos == 40) { if (g < 4) lru_carry_unit(A, g); }
                else { const int k = pos - 73; nsa_unit(A, ll, (g & 3) * 128 + 127 - (2 * k + (g >> 2)), lds); }
            }
            SEAM(pb + 2);
        }
        if (IN(pb + 3)) { constexpr int ll = L;
            for (int rep = 0; rep < DUP_FIN; ++rep) {
            for (int tile = blockIdx.x; tile < T / 64; tile += G) { lru_final_tile(A, ll, tile); group_norm_tile(A, ll, tile, 0); }
            for (int u = blockIdx.x; u < NB * 64; u += G) ssd_final_unit(A, ll, u, lds); }
            SEAM(pb + 3);
        }
        if (IN(pb + 4)) { constexpr int ll = L;
            pg8::Gemm g{(const pg8::bf16_t*)(ws + WS_Y), (const pg8::bf16_t*)(ws + WS_WOUT) + (size_t)ll * D * D, T, D, D, 0};
            pg8::StaticOrder S; S.init(T, D, G, (int)blockIdx.x);
            pg8::EpiResF32 E{ll == 0 ? INF(I_X) : (const float*)A.out, A.out, D, 1.0f};
            pg8::gemm_phase<pg8::EpiResF32, pg8::StaticOrder, true, true>(lds, g, S, E);
            SEAM(pb + 4);
        }
}
__global__ void __launch_bounds__(NTHR, 2) fwd_kernel(Args A) {
    extern __shared__ __attribute__((aligned(16))) unsigned char lds_raw[];
    LAS unsigned char* lds = (LAS unsigned char*)lds_raw;
    const int tid = threadIdx.x, lane = tid & 63, wave = __builtin_amdgcn_readfirstlane(tid >> 6);
    const int G = gridDim.x, gw = blockIdx.x * NWAVES + wave, ngw = G * NWAVES;
    unsigned char* ws = A.ws;
    volatile LAS unsigned* misc = (volatile LAS unsigned*)(lds + LDS_MISC);
    if (tid < 64) misc[tid] = 0u;
    __syncthreads();
    const int lo = A.ph_lo, hi = A.ph_hi;
    XcdBarrier bar; bar.bar = (unsigned*)(ws + WS_CTL) + CW_BAR; bar.x = 0; bar.st = misc;
    if (hi - lo > 1) bar = xcd_barrier_post((unsigned*)(ws + WS_CTL) + CW_BAR, misc);

    if (IN(0)) {
        for (int r2 = 0; r2 < DUP_P0; ++r2) phase_prep_weights(A, lds, gw, ngw, wave, lane);
#if INPROJ_F8
        phase_norm_rows8(INF(I_X), INF(I_NORM_MIX), ws + WS_HN, F8_H, gw, ngw, lane);
#else
        phase_norm_rows(INF(I_X), INF(I_NORM_MIX), (bf16*)(ws + WS_HN), gw, ngw, lane);
#endif
        SEAM(0);
    }
    mixer_phases<0>(A, lds, bar, lo, hi, G);
    {
            if (IN(6)) { phase_norm_rows8(A.out, INF(I_NORM_FFN), ws + WS_HN, F8_H, gw, ngw, lane); SEAM(6); }
            if (IN(7)) {
                pg8::Gemm g{(const pg8::bf16_t*)(ws + WS_HN), (const pg8::bf16_t*)(ws + WS_FGU), T, 2 * DFF, D / 2, 0};
                pg8::StaticOrder S; S.init(T, 2 * DFF, G, (int)blockIdx.x);
                pg8::EpiSwiglu8 E{ws + WS_ACT, DFF / 128, 1.0f / (F8_H * F8_WGU), F8_ACT};
                pg8::gemm_phase<pg8::EpiSwiglu8, pg8::StaticOrder, true, true, true>(lds, g, S, E);
                SEAM(7);
            }
            if (IN(8)) {
                pg8::Gemm g{(const pg8::bf16_t*)(ws + WS_ACT), (const pg8::bf16_t*)(ws + WS_FD), T, D, DFF / 2, 0};
                pg8::StaticOrder S; S.init(T, D, G, (int)blockIdx.x);
                pg8::EpiBf16S E{(pg8::bf16_t*)(ws + WS_DELTA), D, 1.0f / (F8_ACT * F8_WD)};
                pg8::gemm_phase<pg8::EpiBf16S, pg8::StaticOrder, true, true, true, true>(lds, g, S, E);
                SEAM(8);
            }
#if INPROJ_F8
            if (IN(9)) { phase_norm_rows8(A.out, INF(I_NORM_MIX) + D, ws + WS_HN, F8_H, gw, ngw, lane); SEAM(9); }
#else
            if (IN(9)) { phase_add_norm_rows(A.out, (const bf16*)(ws + WS_DELTA), INF(I_NORM_MIX) + D, (bf16*)(ws + WS_HN), gw, ngw, lane); SEAM(9); }
#endif
    }
    mixer_phases<1>(A, lds, bar, lo, hi, G);
#if HAVE_MOE
    if (IN(15)) { moe_router_rows(A, lds, gw, ngw, wave, lane); for (int r2 = 0; r2 < DUP_MOEW; ++r2) moe_prep_weights(A, lds, gw, ngw, wave, lane); SEAM(15); }
    if (IN(16)) { moe_permute_rows(A, gw, ngw, lane); SEAM(16); }
    for (int c = 0; c < 2; ++c) {
        if (IN(17 + 2 * c)) {
            const int* te = (const int*)(ws + WS_TILEE); const int ntile = te[511]; int nt = c == 0 ? (ntile < 128 ? ntile : 128) : (ntile > 128 ? ntile - 128 : 0);
            pg8::Gemm g{(const pg8::bf16_t*)(ws + WS_HPERM + (size_t)c * 32768 * D), (const pg8::bf16_t*)(ws + WS_MWGU), nt * 256, 2 * DFF, D / 2, 0};
            pg8::MoeOrder S; S.init(nt * 256, 2 * DFF, G, (int)blockIdx.x); S.tile_e = te; S.tile0 = 128 * c; S.estride = (size_t)2 * DFF * D;
            pg8::EpiSwiglu8 E{ws + WS_MACT, DFF / 128, 1.0f / (F8_H * F8_WGU), F8_ACT};
            pg8::gemm_phase<pg8::EpiSwiglu8, pg8::MoeOrder, true, true, true>(lds, g, S, E);
            SEAM(17 + 2 * c);
        }
        if (IN(18 + 2 * c)) {
            const int* te = (const int*)(ws + WS_TILEE); const int ntile = te[511]; int nt = c == 0 ? (ntile < 128 ? ntile : 128) : (ntile > 128 ? ntile - 128 : 0); const int ntl = nt > 128 ? nt - 128 : 0; nt -= ntl;
            pg8::EpiMoeDown E{(const int*)(ws + WS_ROWTOK), (const float*)(ws + WS_ROWW), (pg8::bf16_t*)(ws + WS_PARKB), (pg8::bf16_t*)(ws + WS_Y1), c * 32768, 1.0f / (F8_ACT * F8_WD)};
            {   pg8::Gemm g{(const pg8::bf16_t*)(ws + WS_MACT), (const pg8::bf16_t*)(ws + WS_MWD), nt * 256, D, DFF / 2, 0};
                pg8::MoeOrder S; S.init(nt * 256, D, G, (int)blockIdx.x); S.tile_e = te; S.tile0 = 128 * c; S.estride = (size_t)D * DFF;
                pg8::gemm_phase<pg8::EpiMoeDown, pg8::MoeOrder, true, true, true, true>(lds, g, S, E); }
            if (c == 1 && ntl > 0) {
                pg8::Gemm g{(const pg8::bf16_t*)(ws + WS_MACT) + (size_t)128 * 256 * (DFF / 2), (const pg8::bf16_t*)(ws + WS_MWD), ntl * 256, D, DFF / 4, DFF / 128};
                pg8::TailOrder S{te, 256, ntl, G, (int)blockIdx.x, (size_t)D * DFF};
                pg8::EpiMoeDown E2 = E; E2.row0g = 65536;
                pg8::gemm_phase<pg8::EpiMoeDown, pg8::TailOrder, true, true, true, true>(lds, g, S, E2); }
            SEAM(18 + 2 * c);
        }
    }
    if (IN(21)) phase_final_norm_moe(A, gw, ngw, lane);
#else
    if (IN(15)) phase_final_norm(A.out, INF(I_NORM_FINAL), gw, ngw, lane);
#endif
#undef IN
#undef SEAM
}

extern "C" void kernel_launch(void* const* d_in, const int* in_sizes, int n_in, void* d_out, int out_size, void* d_ws, size_t ws_size, hipStream_t stream) {
    static int grid = 0;
    if (grid == 0) {
        if (n_in != N_IN || in_sizes[0] != T * D || out_size != T * D || ws_size < WS_END) {
            fprintf(stderr, "kernel_launch: unexpected problem (n_in %d, in0 %d, out %d, ws %zu); nothing launched\n", n_in, n_in > 0 ? in_sizes[0] : -1, out_size, ws_size); grid = -1; return; }
        int dev = 0, cus = 0, per_cu = 0;
        if (hipGetDevice(&dev) != hipSuccess || hipDeviceGetAttribute(&cus, hipDeviceAttributeMultiprocessorCount, dev) != hipSuccess) { grid = -1; return; }
        if (hipFuncSetAttribute((const void*)fwd_kernel, hipFuncAttributeMaxDynamicSharedMemorySize, LDS_BYTES) != hipSuccess) { fprintf(stderr, "kernel_launch: hipFuncSetAttribute failed\n"); grid = -1; return; }
        if (hipOccupancyMaxActiveBlocksPerMultiprocessor(&per_cu, (const void*)fwd_kernel, NTHR, LDS_BYTES) != hipSuccess || per_cu < 1)
            fprintf(stderr, "kernel_launch: note: occupancy query reports %d workgroups per CU\n", per_cu);
        (void)hipGetLastError();
        grid = cus;
    }
    if (grid < 0) return;
    if (hipMemsetAsync((char*)d_ws + WS_CTL, 0, CTL_BYTES, stream) != hipSuccess) return;
    Args a{};
    for (int i = 0; i < N_IN; ++i) a.in[i] = d_in[i];
    a.out = (float*)d_out; a.ws = (unsigned char*)d_ws;
#if MK_MULTI
#ifndef DUPMASK
#define DUPMASK 0u
#endif
    for (int p = 0; p < N_PHASES; ++p) { a.ph_lo = p; a.ph_hi = p + 1; for (int r = 0; r < (((DUPMASK) >> p) & 1u ? 2 : 1); ++r) hipLaunchKernelGGL(fwd_kernel, dim3(grid), dim3(NTHR), LDS_BYTES, stream, a); }
#else
    a.ph_lo = 0; a.ph_hi = N_PHASES;
    hipLaunchKernelGGL(fwd_kernel, dim3(grid), dim3(NTHR), LDS_BYTES, stream, a);
#endif
}
```

```cpp
#include <hip/hip_runtime.h>
#include <cstdio>
#include <cstdint>
#ifndef EPI_REP
#define EPI_REP 1
#endif
namespace pg8 {
#define PG8_LAS __attribute__((address_space(3)))
typedef unsigned short bf16_t;
typedef short bf16x8 __attribute__((ext_vector_type(8)));
typedef float f32x4 __attribute__((ext_vector_type(4)));
typedef unsigned u32x4 __attribute__((ext_vector_type(4)));
typedef int v4i_t __attribute__((ext_vector_type(4)));
typedef int v8i_t __attribute__((ext_vector_type(8)));
constexpr int BM = 256, BK = 64, HALF = 128, HTB = HALF * BK * 2  , STAGE_BYTES = 8 * HTB, NXCD = 8, WGM = 8;

__host__ __device__ __forceinline__ int lds_byte(int r, int c) { const int st = (r >> 4) * 2 + (c >> 5), rr = r & 15, cc = c & 31, ob = rr * 64 + cc * 2; return st * 1024 + (ob ^ (((ob >> 9) & 1) << 5)); }
__host__ __device__ __forceinline__ void stage_rc(int b, int& R, int& C) { const int st = b / 1024, sb = b % 1024, swz = sb ^ (((sb >> 9) & 1) << 5); R = (st >> 1) * 16 + swz / 64; C = (st & 1) * 32 + (swz % 64) / 2; }
__host__ __device__ __forceinline__ int perm32(int rho) { const int n = rho >> 4, i = rho & 15; return 8 * (i >> 2) + 4 * n + (i & 3); }

struct Unit { int pm, pn, ks; };
struct Gemm { const bf16_t* A; const bf16_t* Bt; int M, N, K; int kt_full; };

struct StaticOrder {
    static constexpr bool ROT = false; __device__ __forceinline__ int krot(const Unit&) const { return 0; }
    int nM, nN, nwg, G, c;
    __host__ __device__ void init(int M, int N, int G_, int c_) { nM = M / BM; nN = N / BM; nwg = nM * nN; G = G_; c = c_; }
    __host__ __device__ bool next(int i, Unit& u) const {
        const long L = (long)i * G + c; if (L >= nwg) return false;
        int wgid = (int)L; { const int q = nwg / NXCD, r = nwg % NXCD, xcd = wgid % NXCD, off = wgid / NXCD; wgid = (xcd < r ? xcd * (q + 1) : r * (q + 1) + (xcd - r) * q) + off; }
        const int nig = WGM * nN, gid = wgid / nig, fm = gid * WGM, gsz = (nM - fm) < WGM ? (nM - fm) : WGM;
        u.pm = fm + ((wgid % nig) % gsz); u.pn = (wgid % nig) / gsz; u.ks = 0; return true;
    }
    __device__ __forceinline__ void a_ready(const Unit&) const {}
    __device__ __forceinline__ void done(const Unit&) const {}
    __device__ __forceinline__ size_t bofs(const Unit&) const { return 0; }
};

__device__ __forceinline__ unsigned cvt_pk_bf16(float lo, float hi) { unsigned r; asm volatile("v_cvt_pk_bf16_f32 %0, %1, %2" : "=v"(r) : "v"(lo), "v"(hi)); return r; }
typedef float f32x2 __attribute__((ext_vector_type(2)));
__device__ __forceinline__ f32x2 gelu_pk(f32x2 v) {
    const f32x2 av = __builtin_elementwise_abs(v), d = av * 0.2316418882f + 1.0f;
    f32x2 t; t.x = __builtin_amdgcn_rcpf(d.x); t.y = __builtin_amdgcn_rcpf(d.y);
    f32x2 q = t * 0.5307027145f + (-0.7265760135f); q = q * t + 0.7107068705f; q = q * t + (-0.142248368f); q = q * t + 0.127414796f; q = q * t;
    const f32x2 s = (v * v) * (-0.72134752044f);
    f32x2 e; e.x = __builtin_amdgcn_exp2f(s.x); e.y = __builtin_amdgcn_exp2f(s.y);
    const f32x2 m = v * (q * e), r = v - m;
    f32x2 o; o.x = v.x < 0.f ? m.x : r.x; o.y = v.y < 0.f ? m.y : r.y; return o;
}

template <int ACT  > struct EpiBf16 {
    static constexpr bool PERM = true, AFTER_DRAIN = false, IDEM = true; static_assert(ACT == 0 || ACT == 1, "EpiBf16: ACT is 0 (none) or 1 (gelu_pk)");
    bf16_t* O; int ldc; const float* bias; int split_cols; size_t split_stride; float scale0;
    __device__ __forceinline__ void operator()(const f32x4 (&acc)[2][2][4][2], const Unit& u, int wr, int wc, int fr, int fq) const {
        const int row0 = u.pm * BM + wr * 64 + fr; int colt = u.pn * BM; bf16_t* base = O;
        float sc = 1.f; if (split_cols) { const int t = colt / split_cols; base += (size_t)t * split_stride; colt -= t * split_cols; if (t == 0) sc = scale0; }
        const int col0 = colt + wc * 32 + 8 * fq, bcol0 = u.pn * BM + wc * 32 + 8 * fq;
        f32x4 bv[2][2];
#pragma unroll
        for (int bj = 0; bj < 2; ++bj)
#pragma unroll
            for (int n = 0; n < 2; ++n) bv[bj][n] = bias ? *(const f32x4*)(bias + bcol0 + bj * HALF + 4 * n) : (f32x4){0.f, 0.f, 0.f, 0.f};
#pragma unroll
        for (int ai = 0; ai < 2; ++ai)
#pragma unroll
            for (int m = 0; m < 4; ++m) { bf16_t* rowp = base + (size_t)(row0 + ai * HALF + m * 16) * ldc + col0;
#pragma unroll
                for (int bj = 0; bj < 2; ++bj) { f32x4 v0 = acc[ai][bj][m][0] + bv[bj][0], v1 = acc[ai][bj][m][1] + bv[bj][1];
                    if (ACT == 1) { f32x2 a = gelu_pk((f32x2){v0[0], v0[1]}), b = gelu_pk((f32x2){v0[2], v0[3]}), c = gelu_pk((f32x2){v1[0], v1[1]}), d = gelu_pk((f32x2){v1[2], v1[3]});
                        v0 = (f32x4){a.x, a.y, b.x, b.y}; v1 = (f32x4){c.x, c.y, d.x, d.y}; }
                    v0 = v0 * sc; v1 = v1 * sc; u32x4 w; w.x = cvt_pk_bf16(v0[0], v0[1]); w.y = cvt_pk_bf16(v0[2], v0[3]); w.z = cvt_pk_bf16(v1[0], v1[1]); w.w = cvt_pk_bf16(v1[2], v1[3]);
                    *(u32x4*)(rowp + bj * HALF) = w; } }
    }
};
template <class Epi, class Sched, bool ALIGN_EPI = false, bool SP2 = false, bool F8 = false, bool BLK = false>
__device__ __forceinline__ void gemm_phase(PG8_LAS unsigned char* lds, const Gemm g, const Sched& S, const Epi& E) {
    const int tid = threadIdx.x, wid = __builtin_amdgcn_readfirstlane(tid >> 6), lane = tid & 63, wr = wid >> 2, wc = wid & 3, fr = lane & 15, fq = lane >> 4;
    const int K = g.K, nt = K / BK;
    unsigned voffA[2], voffB[2];
#pragma unroll
    for (int i = 0; i < 2; ++i) { int R, C; stage_rc(tid * 16 + i * 8192, R, C); const int Rb = Epi::PERM ? ((R & ~31) + perm32(R & 31)) : R;
        voffA[i] = BLK ? (unsigned)(R * 64 + C) * 2u : (unsigned)(R * K + C) * 2u; voffB[i] = BLK ? (unsigned)(Rb * 64 + C) * 2u : (unsigned)(Rb * K + C) * 2u; }
    const size_t kstep = BLK ? (size_t)32768 : (size_t)(BK * 2);
    const size_t hstep = BLK ? (size_t)16384 : (size_t)HALF * K * 2;
    const size_t tstep = BLK ? (size_t)(g.kt_full ? g.kt_full : nt) * 32768 : 2 * hstep;
    const size_t sstep = BLK ? (size_t)nt * 32768 : 0;
    const unsigned ldsw = (unsigned)wid * 1024u;
    const int aoff = lds_byte(wr * 64 + fr, fq * 8), boff = lds_byte(wc * 32 + fr, fq * 8);
#define PG8_SA(b, h) (((b) * 2 + (h)) * HTB)
#define PG8_SB(b, h) ((4 + (b) * 2 + (h)) * HTB)
#define PG8_STAGE(bufoff, gbase, voff) do { _Pragma("unroll") for (int _i = 0; _i < 2; ++_i) \
        __builtin_amdgcn_global_load_lds((const unsigned*)((const char*)(gbase) + (voff)[_i]), (PG8_LAS unsigned*)(lds + (bufoff) + ldsw + _i * 8192), 16, 0, 0); } while (0)
#define PG8_LDA(dst, b, h) do { if constexpr (F8) { _Pragma("unroll") for (int m = 0; m < 4; ++m) dst##_8[m] = __builtin_shufflevector(*(const PG8_LAS v4i_t*)(lds + PG8_SA(b, h) + aoff + m * 2048), *(const PG8_LAS v4i_t*)(lds + PG8_SA(b, h) + aoff + m * 2048 + 1024), 0, 1, 2, 3, 4, 5, 6, 7); } \
        else { _Pragma("unroll") for (int m = 0; m < 4; ++m) _Pragma("unroll") for (int k = 0; k < 2; ++k) dst[m][k] = *(const PG8_LAS bf16x8*)(lds + PG8_SA(b, h) + aoff + m * 2048 + k * 1024); } } while (0)
#define PG8_LDB(dst, b, h) do { if constexpr (F8) { _Pragma("unroll") for (int n = 0; n < 2; ++n) dst##_8[n] = __builtin_shufflevector(*(const PG8_LAS v4i_t*)(lds + PG8_SB(b, h) + boff + n * 2048), *(const PG8_LAS v4i_t*)(lds + PG8_SB(b, h) + boff + n * 2048 + 1024), 0, 1, 2, 3, 4, 5, 6, 7); } \
        else { _Pragma("unroll") for (int n = 0; n < 2; ++n) _Pragma("unroll") for (int k = 0; k < 2; ++k) dst[n][k] = *(const PG8_LAS bf16x8*)(lds + PG8_SB(b, h) + boff + n * 2048 + k * 1024); } } while (0)
#define PG8_MMA(ai, bj, At, Bt) do { __builtin_amdgcn_s_setprio(1); \
        if constexpr (F8) { _Pragma("unroll") for (int m = 0; m < 4; ++m) _Pragma("unroll") for (int n = 0; n < 2; ++n) \
            asm volatile("v_mfma_scale_f32_16x16x128_f8f6f4 %0, %1, %2, %0, %3, %3 op_sel_hi:[0,0,0]" : "+v"(acc[ai][bj][m][n]) : "v"(Bt##_8[n]), "v"(At##_8[m]), "v"(f8sc)); }   \
        else { _Pragma("unroll") for (int m = 0; m < 4; ++m) _Pragma("unroll") for (int n = 0; n < 2; ++n) _Pragma("unroll") for (int k = 0; k < 2; ++k) \
            acc[ai][bj][m][n] = __builtin_amdgcn_mfma_f32_16x16x32_bf16(Bt[n][k], At[m][k], acc[ai][bj][m][n], 0, 0, 0); } \
        __builtin_amdgcn_s_setprio(0); } while (0)
#define PG8_WAIT_V(n) asm volatile("s_waitcnt vmcnt(" #n ")" ::: "memory")
#define PG8_WAIT_L(n) asm volatile("s_waitcnt lgkmcnt(" #n ")" ::: "memory")
#define PG8_BAR __builtin_amdgcn_s_barrier()
#define PG8_SCHED __builtin_amdgcn_sched_barrier(0)
    Unit cur, nxt; int ui = 0;
    if (!S.next(0, cur)) return;
    f32x4 acc[2][2][4][2];
#pragma unroll
    for (int a = 0; a < 2; ++a)
#pragma unroll
        for (int b = 0; b < 2; ++b)
#pragma unroll
            for (int m = 0; m < 4; ++m)
#pragma unroll
                for (int n = 0; n < 2; ++n) acc[a][b][m][n] = (f32x4){0.f, 0.f, 0.f, 0.f};
    const int f8sc = 0x7f7f7f7f;
    bf16x8 At[4][2], B0[2][2], B1[2][2]; v8i_t At_8[4], B0_8[2], B1_8[2];
    const char* cA = (const char*)g.A + (size_t)cur.pm * tstep + (size_t)cur.ks * sstep; const char* cB = (const char*)g.Bt + S.bofs(cur) + (size_t)cur.pn * tstep + (size_t)cur.ks * sstep;
    S.a_ready(cur);
    if constexpr (SP2) {
        PG8_STAGE(PG8_SB(0, 0), cB, voffB); PG8_STAGE(PG8_SB(0, 1), cB + hstep, voffB); PG8_STAGE(PG8_SA(0, 0), cA, voffA); PG8_STAGE(PG8_SA(0, 1), cA + hstep, voffA);
        if (wr == 1) PG8_BAR;
        PG8_WAIT_V(2); PG8_BAR;
        PG8_STAGE(PG8_SB(1, 0), cB + kstep, voffB); PG8_STAGE(PG8_SA(1, 0), cA + kstep, voffA); PG8_STAGE(PG8_SB(1, 1), cB + hstep + kstep, voffB);
        PG8_WAIT_V(6); PG8_BAR;
    } else {
        PG8_STAGE(PG8_SB(0, 0), cB, voffB); PG8_STAGE(PG8_SA(0, 0), cA, voffA); PG8_STAGE(PG8_SB(0, 1), cB + hstep, voffB); PG8_STAGE(PG8_SA(0, 1), cA + hstep, voffA);
        if (wr == 1) PG8_BAR;
        PG8_WAIT_V(4); PG8_BAR;
        PG8_STAGE(PG8_SB(1, 0), cB + kstep, voffB); PG8_STAGE(PG8_SA(1, 0), cA + kstep, voffA); PG8_STAGE(PG8_SB(1, 1), cB + hstep + kstep, voffB);
        PG8_WAIT_V(6); PG8_BAR;
    }
    for (;;) {
        const bool has_next = S.next(ui + 1, nxt);
        const char* nA = has_next ? (const char*)g.A + (size_t)nxt.pm * tstep + (size_t)nxt.ks * sstep : cA; const char* nB = has_next ? (const char*)g.Bt + S.bofs(nxt) + (size_t)nxt.pn * tstep + (size_t)nxt.ks * sstep : cB;
#pragma nounroll
        for (int t = 0; t < nt; t += 2) {
            const bool last = (t == nt - 2);
            const char* a1 = cA + (size_t)(t + 1) * kstep;
            const char* a2 = last ? nA : cA + (size_t)(t + 2) * kstep; const char* b2 = last ? nB : cB + (size_t)(t + 2) * kstep;
            const char* a3 = a2 + kstep; const char* b3 = b2 + kstep;
            if (last && has_next) S.a_ready(nxt);
            if constexpr (SP2) {
            PG8_LDB(B0, 0, 0); PG8_LDB(B1, 0, 1); PG8_SCHED; PG8_LDA(At, 0, 0); PG8_STAGE(PG8_SA(1, 1), a1 + hstep, voffA);
            PG8_WAIT_V(8); PG8_WAIT_L(0); PG8_BAR; PG8_MMA(0, 0, At, B0); PG8_MMA(0, 1, At, B1); PG8_BAR; PG8_SCHED;
            PG8_LDA(At, 0, 1); PG8_STAGE(PG8_SB(0, 0), b2, voffB); PG8_STAGE(PG8_SB(0, 1), b2 + hstep, voffB); PG8_STAGE(PG8_SA(0, 0), a2, voffA);
            PG8_WAIT_V(8); PG8_WAIT_L(0); PG8_BAR; PG8_MMA(1, 0, At, B0); PG8_MMA(1, 1, At, B1); PG8_BAR; PG8_SCHED;
            PG8_LDB(B0, 1, 0); PG8_LDB(B1, 1, 1); PG8_SCHED; PG8_LDA(At, 1, 0); PG8_STAGE(PG8_SA(0, 1), a2 + hstep, voffA);
            PG8_WAIT_V(8); PG8_WAIT_L(0); PG8_BAR; PG8_MMA(0, 0, At, B0); PG8_MMA(0, 1, At, B1); PG8_BAR; PG8_SCHED;
            PG8_LDA(At, 1, 1); PG8_STAGE(PG8_SB(1, 0), b3, voffB); PG8_STAGE(PG8_SB(1, 1), b3 + hstep, voffB); PG8_STAGE(PG8_SA(1, 0), a3, voffA);
            PG8_WAIT_V(8); PG8_WAIT_L(0); PG8_BAR; PG8_MMA(1, 0, At, B0); PG8_MMA(1, 1, At, B1); PG8_BAR; PG8_SCHED;
            } else {
            PG8_LDB(B0, 0, 0); PG8_SCHED; PG8_LDA(At, 0, 0); PG8_STAGE(PG8_SA(1, 1), a1 + hstep, voffA);
            PG8_WAIT_L(8); PG8_BAR; PG8_WAIT_L(0); PG8_MMA(0, 0, At, B0); PG8_BAR; PG8_SCHED;
            PG8_LDB(B1, 0, 1); PG8_STAGE(PG8_SB(0, 0), b2, voffB);
            PG8_BAR; PG8_WAIT_L(0); PG8_MMA(0, 1, At, B1); PG8_BAR;
            PG8_LDA(At, 0, 1); PG8_STAGE(PG8_SA(0, 0), a2, voffA);
            PG8_BAR; PG8_WAIT_L(0); PG8_MMA(1, 0, At, B0); PG8_BAR; PG8_SCHED;
            PG8_STAGE(PG8_SB(0, 1), b2 + hstep, voffB);
            PG8_WAIT_V(6); PG8_BAR; PG8_MMA(1, 1, At, B1); PG8_BAR;
            PG8_LDB(B0, 1, 0); PG8_SCHED; PG8_LDA(At, 1, 0); PG8_STAGE(PG8_SA(0, 1), a2 + hstep, voffA);
            PG8_WAIT_L(8); PG8_BAR; PG8_WAIT_L(0); PG8_MMA(0, 0, At, B0); PG8_BAR; PG8_SCHED;
            PG8_LDB(B1, 1, 1); PG8_STAGE(PG8_SB(1, 0), b3, voffB);
            PG8_BAR; PG8_WAIT_L(0); PG8_MMA(0, 1, At, B1); PG8_BAR;
            PG8_LDA(At, 1, 1); PG8_STAGE(PG8_SA(1, 0), a3, voffA);
            PG8_BAR; PG8_WAIT_L(0); PG8_MMA(1, 0, At, B0); PG8_BAR; PG8_SCHED;
            PG8_STAGE(PG8_SB(1, 1), b3 + hstep, voffB);
            PG8_WAIT_V(6); PG8_BAR; PG8_MMA(1, 1, At, B1); PG8_BAR;
            }
        }
        if constexpr (F8) asm volatile("s_nop 15\n\ts_nop 15\n\ts_nop 15\n\ts_nop 15\n\ts_nop 15" ::: "memory");
        if constexpr (ALIGN_EPI) { if (wr == 0) PG8_BAR; }
        if constexpr (!Epi::AFTER_DRAIN) { for (int er_ = 0; er_ < (Epi::IDEM ? EPI_REP : 1); ++er_) E(acc, cur, wr, wc, fr, fq); S.done(cur); }
        if (!has_next) break;
#pragma unroll
        for (int a = 0; a < 2; ++a)
#pragma unroll
            for (int b = 0; b < 2; ++b)
#pragma unroll
                for (int m = 0; m < 4; ++m)
#pragma unroll
                    for (int n = 0; n < 2; ++n) acc[a][b][m][n] = (f32x4){0.f, 0.f, 0.f, 0.f};
        cur = nxt; cA = nA; cB = nB; ++ui;
        if constexpr (ALIGN_EPI) { if (wr == 1) PG8_BAR; }
    }
    PG8_WAIT_V(0);
    if constexpr (!ALIGN_EPI) { if (wr == 0) PG8_BAR; }
    PG8_BAR;
    if constexpr (Epi::AFTER_DRAIN) { E.fused(acc, cur, wr, wc, fr, fq, lds, wid, lane); S.done(cur); }
#undef PG8_SA
#undef PG8_SB
#undef PG8_STAGE
#undef PG8_LDA
#undef PG8_LDB
#undef PG8_MMA
#undef PG8_WAIT_V
#undef PG8_WAIT_L
#undef PG8_BAR
#undef PG8_SCHED
}
}

#define LAS __attribute__((address_space(3)))
typedef unsigned short bf16;
typedef short bf16x8 __attribute__((ext_vector_type(8)));
typedef float f32x4 __attribute__((ext_vector_type(4)));
typedef float f32x16 __attribute__((ext_vector_type(16)));
typedef unsigned u32x4 __attribute__((ext_vector_type(4)));
typedef unsigned u32x2 __attribute__((ext_vector_type(2)));

constexpr int NB = 4, SEQ = 8192, T = NB * SEQ, D = 1024, DEPTH = 2;
constexpr int INC = 2560, IN_COLS = 2544;
constexpr int U_CQ = 0, U_CKV = 192, U_KPE = 320, U_NQ = 352, U_NKV = 608, U_NG = 992, U_LX = 1008, U_LG = 1264,
              U_SZ = 1520, U_SX = 1776, U_SB = 2032, U_SC = 2288, U_SDT = 2544;
constexpr int DFF = 3584, NEXP = 8;
constexpr float EPS = 1e-6f;
#ifndef INPROJ_SPLIT
#define INPROJ_SPLIT 0
#endif
#ifndef INPROJ_F8
#define INPROJ_F8 0
#endif
constexpr float F8_H = 16.f, F8_WGU = 256.f, F8_ACT = 8.f, F8_WD = 512.f;
constexpr int NWAVES = 8, NTHR = 512;
constexpr int LDS_BYTES = 163840;
constexpr int LDS_MISC = 163840 - 1024;

enum { I_X = 0, I_POS, I_NORM_MIX, I_W_IN, I_MLA_QN, I_MLA_WUQ, I_MLA_KVN, I_MLA_WUKV, I_NSA_PE, I_NSA_WCMP, I_LRU_CW, I_LRU_CB, I_LRU_WG, I_LRU_BG,
       I_LRU_LAM, I_SSD_CW, I_SSD_CB, I_SSD_DTB, I_SSD_ALOG, I_SSD_D, I_GNORM, I_W_OUT, I_NORM_FFN, I_FFN_WG, I_FFN_WU, I_FFN_WD, I_MOE_R, I_MOE_WG,
       I_MOE_WU, I_MOE_WD, I_NORM_FINAL, N_IN };

constexpr size_t MiB = 1u << 20;
constexpr size_t WS_CTL = 0, CTL_BYTES = 1 * MiB;
constexpr size_t WS_WIN = 1 * MiB;
constexpr size_t WS_WOUT = 11 * MiB;
constexpr size_t WS_FGU = 15 * MiB;
constexpr size_t WS_FD = 29 * MiB;
constexpr size_t WS_WIN8 = 33 * MiB;
constexpr size_t WS_HN8 = 234 * MiB;
constexpr size_t WS_MISC = 36 * MiB;
constexpr size_t WS_WUQ = WS_MISC;
constexpr size_t WS_WUKV = WS_WUQ + 2 * 384 * 192 * 2;
constexpr size_t WS_WCT = WS_WUKV + 2 * 512 * 128 * 2;
constexpr size_t WS_BIASC = WS_WCT + 4 * 64 * 2048 * 2;
constexpr size_t WS_WGT = WS_BIASC + 4 * 64 * 4;
constexpr size_t WS_ROPEM = WS_MISC + 2 * MiB;
constexpr size_t WS_ROPEN = WS_MISC + 3 * MiB;
static_assert(WS_WGT + 2 * 2 * 4 * 64 * 64 * 2 <= WS_ROPEM, "misc weights");
constexpr size_t WS_ARENA = 42 * MiB;
constexpr size_t WS_U = WS_ARENA;
constexpr size_t WS_Y = 202 * MiB;
constexpr size_t WS_HN = 266 * MiB;
constexpr size_t WS_MQ = 330 * MiB, WS_MK = 354 * MiB, WS_MVT = 378 * MiB;
constexpr size_t WS_NQ = 394 * MiB, WS_NKS = 410 * MiB, WS_NKW = 414 * MiB, WS_NVTS = 418 * MiB, WS_NVTW = 422 * MiB, WS_NKC = 426 * MiB, WS_NVCT = 427 * MiB, WS_NGATE = 428 * MiB;
constexpr size_t WS_LHL = 430 * MiB, WS_LPC = 446 * MiB, WS_LACH = 462 * MiB, WS_LHCH = WS_LACH + 512 * 1024, WS_LCIN = WS_LHCH + 512 * 1024;
constexpr size_t WS_SST = 464 * MiB, WS_STT = 496 * MiB;
constexpr size_t WS_SHIN = WS_HN;
constexpr size_t WS_MRAW = WS_HN + 32 * MiB;
constexpr size_t WS_DELTA = 160 * MiB;
constexpr size_t WS_ACT = WS_ARENA;
constexpr size_t WS_END = 512 * MiB;

constexpr int CW_BAR = 4096;
constexpr int CW_Q = 8192;
constexpr int CW_KMAX_UNUSED = 10240;

__device__ __forceinline__ float bf2f(bf16 v) { return __uint_as_float(((unsigned)v) << 16); }

typedef float f32x2_t __attribute__((ext_vector_type(2))); typedef __bf16 bf16x2_t __attribute__((ext_vector_type(2)));
__device__ __forceinline__ unsigned pk2(float lo, float hi) { f32x2_t v = {lo, hi}; bf16x2_t b = __builtin_convertvector(v, bf16x2_t); return __builtin_bit_cast(unsigned, b); }
__device__ __forceinline__ unsigned f2bf(float f) { return pk2(f, 0.f) & 0xffffu; }
__device__ __forceinline__ float lo_bf(unsigned w) { return __uint_as_float(w << 16); }
__device__ __forceinline__ float hi_bf(unsigned w) { return __uint_as_float(w & 0xffff0000u); }
__device__ __forceinline__ int crow(int r, int hi) { return (r & 3) + 8 * (r >> 2) + 4 * hi; }
#define MFMA32(a, b, c) __builtin_amdgcn_mfma_f32_32x32x16_bf16(a, b, c, 0, 0, 0)
#define MFMA16(a, b, c) __builtin_amdgcn_mfma_f32_16x16x32_bf16(a, b, c, 0, 0, 0)
#define LDS_WAIT() asm volatile("s_waitcnt lgkmcnt(0)" ::: "memory")
#define WG_BAR() do { asm volatile("s_waitcnt lgkmcnt(0)" ::: "memory"); __builtin_amdgcn_s_barrier(); asm volatile("" ::: "memory"); } while (0)
__device__ __forceinline__ float wave_sum(float v) {
#pragma unroll
    for (int o = 1; o < 64; o <<= 1) v += __shfl_xor(v, o);
    return v;
}
constexpr int CW_KMG = 16384, KM_WORDS = 96;
__device__ __forceinline__ void kmax_update(LAS unsigned* kml, int word, float v) { __hip_atomic_fetch_max(kml + word, __float_as_uint(v), __ATOMIC_RELAXED, __HIP_MEMORY_SCOPE_WORKGROUP); }
__device__ __forceinline__ float kmax_read(const unsigned char* ws, int l, int word, int lane, int G) {
    const unsigned* p = (const unsigned*)(ws + WS_CTL) + CW_KMG + (size_t)(l * KM_WORDS + word) * 256; unsigned m = 0u;
    for (int i = lane; i < G && i < 256; i += 64) { const unsigned v = p[i]; m = v > m ? v : m; }
#pragma unroll
    for (int o = 1; o < 64; o <<= 1) { const unsigned t = (unsigned)__shfl_xor((int)m, o); m = t > m ? t : m; }
    return __uint_as_float(m);
}
__device__ __forceinline__ float sigmoidf_(float x) { return __builtin_amdgcn_rcpf(1.0f + __expf(-x)); }

#define XB_TMO      128
#define XB_XCNT(j)  (256  + 64 * (j))
#define XB_XSUB(j)  (1280 + 64 * (j))
#define XB_XGEN(j)  (2304 + 64 * (j))
#define XB_TOP      3328
#define XB_TOPGEN   3392
#define XCD_BAR_WORDS 3456
#define XB_SPIN_CAP (1u << 18)
__device__ __forceinline__ unsigned xb_ld(unsigned* p)              { return __hip_atomic_load(p, __ATOMIC_RELAXED, __HIP_MEMORY_SCOPE_AGENT); }
__device__ __forceinline__ unsigned xb_add(unsigned* p, unsigned v) { return __hip_atomic_fetch_add(p, v, __ATOMIC_RELAXED, __HIP_MEMORY_SCOPE_AGENT); }
__device__ __forceinline__ unsigned xb_xcc_id() { return (unsigned)__builtin_amdgcn_s_getreg((3 << 11) | 20) & 0xFu; }
#define XB_SPIN(cond, bar) do { unsigned _sp = 0; while (cond) { __builtin_amdgcn_s_sleep(1); \
    if ((++_sp & 255u) == 0u) { if (xb_ld(&(bar)[XB_TMO])) break; if (_sp > XB_SPIN_CAP) { atomicAdd(&(bar)[XB_TMO], 1u); break; } } } } while (0)
struct XcdBarrier { unsigned* bar; unsigned x; volatile LAS unsigned* st; };
__device__ __forceinline__ XcdBarrier xcd_barrier_post(unsigned* bar, volatile LAS unsigned* st) {
    XcdBarrier b; b.bar = bar; b.x = xb_xcc_id(); b.st = st;
    if (threadIdx.x == 0) (void)xb_add(&bar[XB_XCNT(b.x)], 1u);
    return b;
}
__device__ __forceinline__ void xcd_barrier_complete(unsigned* bar, unsigned x, unsigned& nloc, unsigned& nx) {
    const unsigned G = gridDim.x * gridDim.y * gridDim.z;
    unsigned sum, cnt, mine, sp = 0u;
    for (;;) {
        sum = 0u; cnt = 0u; mine = 0u;
#pragma unroll
        for (unsigned j = 0; j < 16; ++j) { const unsigned c = xb_ld(&bar[XB_XCNT(j)]); sum += c; cnt += (c > 0u) ? 1u : 0u; mine = (j == x) ? c : mine; }
        if (sum == G) break;
        __builtin_amdgcn_s_sleep(1);
        if ((++sp & 255u) == 0u) { if (xb_ld(&bar[XB_TMO])) break; if (sp > XB_SPIN_CAP) { atomicAdd(&bar[XB_TMO], 1u); break; } }
    }
    nloc = mine > 0u ? mine : 1u; nx = cnt > 0u ? cnt : 1u;
}
__device__ __forceinline__ void xcd_barrier(const XcdBarrier& b) {
    asm volatile("s_waitcnt vmcnt(0)" ::: "memory");
    __syncthreads();
    if (threadIdx.x == 0) {
        unsigned* bar = b.bar;
        __builtin_amdgcn_s_waitcnt(0);
        unsigned nloc = b.st[0], nx = b.st[1];
        if (nloc == 0u) { xcd_barrier_complete(bar, b.x, nloc, nx); b.st[0] = nloc; b.st[1] = nx; }
        const unsigned old = xb_add(&bar[XB_XSUB(b.x)], 1u);
        const unsigned gen = old / nloc;
        if (old + 1u == (gen + 1u) * nloc) {
            __builtin_amdgcn_fence(__ATOMIC_RELEASE, "agent");
            asm volatile("s_waitcnt vmcnt(0)" ::: "memory");
            const unsigned og = xb_add(&bar[XB_TOP], 1u);
            const unsigned tg = og / nx;
            if (og + 1u == (tg + 1u) * nx) xb_add(&bar[XB_TOPGEN], 1u);
            else XB_SPIN(xb_ld(&bar[XB_TOPGEN]) == tg, bar);
            __builtin_amdgcn_fence(__ATOMIC_ACQUIRE, "agent");
            xb_add(&bar[XB_XGEN(b.x)], 1u);
            asm volatile("s_waitcnt vmcnt(0)" ::: "memory");
        } else {
            XB_SPIN(xb_ld(&bar[XB_XGEN(b.x)]) == gen, bar);
            __builtin_amdgcn_fence(__ATOMIC_ACQUIRE, "agent");
            asm volatile("s_waitcnt vmcnt(0)" ::: "memory");
        }
    }
    __syncthreads();
}

struct Args { const void* in[N_IN]; float* out; unsigned char* ws; int ph_lo, ph_hi; };
#define INF(i) ((const float*)A.in[i])

namespace pg8 {
struct EpiResF32 {
    static constexpr bool PERM = false, AFTER_DRAIN = false, IDEM = false;
    const float* base; float* out; int ldc; float scale;
    __device__ __forceinline__ void operator()(const f32x4 (&acc)[2][2][4][2], const Unit& u, int wr, int wc, int fr, int fq) const {
        const int row0 = u.pm * BM + wr * 64 + fr, col0 = u.pn * BM + wc * 32 + 4 * fq;
        f32x4 bs[2][8];
#define ERF_OFF(g, k) ((size_t)(row0 + ((g) >> 1) * HALF + (2 * ((g) & 1) + ((k) >> 2)) * 16) * ldc + col0 + (((k) >> 1) & 1) * HALF + ((k) & 1) * 16)
#pragma unroll
        for (int k = 0; k < 8; ++k) bs[0][k] = *(const f32x4*)(base + ERF_OFF(0, k));
#pragma unroll
        for (int g = 0; g < 4; ++g) {
            if (g < 3) {
#pragma unroll
                for (int k = 0; k < 8; ++k) bs[(g + 1) & 1][k] = *(const f32x4*)(base + ERF_OFF(g + 1, k)); }
            __builtin_amdgcn_sched_barrier(0);
#pragma unroll
            for (int k = 0; k < 8; ++k) *(f32x4*)(out + ERF_OFF(g, k)) = bs[g & 1][k] + acc[g >> 1][(k >> 1) & 1][2 * (g & 1) + (k >> 2)][k & 1] * scale;
            __builtin_amdgcn_sched_barrier(0);
        }
#undef ERF_OFF
    }
};
struct EpiSwiglu {
    static constexpr bool PERM = true, AFTER_DRAIN = false, IDEM = true;
    bf16_t* O; int ldc;
    __device__ __forceinline__ void operator()(const f32x4 (&acc)[2][2][4][2], const Unit& u, int wr, int wc, int fr, int fq) const {
        const int row0 = u.pm * BM + wr * 64 + fr, col0 = u.pn * HALF + wc * 32 + 8 * fq;
#pragma unroll
        for (int ai = 0; ai < 2; ++ai)
#pragma unroll
            for (int m = 0; m < 4; ++m) { bf16_t* rowp = O + (size_t)(row0 + ai * HALF + m * 16) * ldc + col0;
                float v[8];
#pragma unroll
                for (int n = 0; n < 2; ++n)
#pragma unroll
                    for (int j = 0; j < 4; ++j) { const float g = acc[ai][0][m][n][j], up = acc[ai][1][m][n][j]; v[4 * n + j] = g * up * __builtin_amdgcn_rcpf(1.0f + __expf(-g)); }
                u32x4 w; w.x = cvt_pk_bf16(v[0], v[1]); w.y = cvt_pk_bf16(v[2], v[3]); w.z = cvt_pk_bf16(v[4], v[5]); w.w = cvt_pk_bf16(v[6], v[7]);
                *(u32x4*)rowp = w; }
    }
};
struct EpiBf16S {
    static constexpr bool PERM = true, AFTER_DRAIN = false, IDEM = true;
    bf16_t* O; int ldc; float scale;
    __device__ __forceinline__ void operator()(const f32x4 (&acc)[2][2][4][2], const Unit& u, int wr, int wc, int fr, int fq) const {
        const int row0 = u.pm * BM + wr * 64 + fr, col0 = u.pn * BM + wc * 32 + 8 * fq;
#pragma unroll
        for (int ai = 0; ai < 2; ++ai)
#pragma unroll
            for (int m = 0; m < 4; ++m) { bf16_t* rowp = O + (size_t)(row0 + ai * HALF + m * 16) * ldc + col0;
#pragma unroll
                for (int bj = 0; bj < 2; ++bj) { const f32x4 v0 = acc[ai][bj][m][0] * scale, v1 = acc[ai][bj][m][1] * scale;
                    u32x4 w; w.x = cvt_pk_bf16(v0[0], v0[1]); w.y = cvt_pk_bf16(v0[2], v0[3]); w.z = cvt_pk_bf16(v1[0], v1[1]); w.w = cvt_pk_bf16(v1[2], v1[3]);
                    *(u32x4*)(rowp + bj * HALF) = w; } }
    }
};
struct EpiSwiglu8 {
    static constexpr bool PERM = true, AFTER_DRAIN = false, IDEM = true;
    unsigned char* O; int nkt; float s_in, s_out;
    __device__ __forceinline__ void operator()(const f32x4 (&acc)[2][2][4][2], const Unit& u, int wr, int wc, int fr, int fq) const {
        unsigned char* const Ob = O + ((size_t)(u.pm * nkt + u.pn) * 256 + wr * 64 + fr) * 128 + wc * 32 + 8 * fq;
#pragma unroll
        for (int ai = 0; ai < 2; ++ai)
#pragma unroll
            for (int m = 0; m < 4; ++m) { unsigned char* rowp = Ob + (ai * HALF + m * 16) * 128;
                float v[8];
#pragma unroll
                for (int n = 0; n < 2; ++n)
#pragma unroll
                    for (int j = 0; j < 4; ++j) { const float ga = acc[ai][0][m][n][j], g = ga * s_in, u2 = acc[ai][1][m][n][j] * (s_in * s_out);     v[4 * n + j] = fminf(fmaxf(g * __builtin_amdgcn_rcpf(1.0f + __builtin_amdgcn_exp2f(ga * (-1.4426950408889634f * s_in))) * u2, -448.f), 448.f); }
                int p0 = 0, p1 = 0; p0 = __builtin_amdgcn_cvt_pk_fp8_f32(v[0], v[1], p0, false); p0 = __builtin_amdgcn_cvt_pk_fp8_f32(v[2], v[3], p0, true);
                p1 = __builtin_amdgcn_cvt_pk_fp8_f32(v[4], v[5], p1, false); p1 = __builtin_amdgcn_cvt_pk_fp8_f32(v[6], v[7], p1, true);
                u32x2 w; w.x = (unsigned)p0; w.y = (unsigned)p1; *(u32x2*)rowp = w; }
    }
};
struct RowOrder4 { static constexpr bool ROT = true; __device__ __forceinline__ int krot(const Unit& u) const { return u.pm * 5 + u.pn * 3; } int nwg, G, c;
    __device__ __forceinline__ bool next(int i, Unit& u) const { const long L = (long)i * G + c; if (L >= nwg) return false; u.pm = (int)(L >> 2); u.pn = (int)(L & 3); u.ks = 0; return true; }
    __device__ __forceinline__ void a_ready(const Unit&) const {}
    __device__ __forceinline__ void done(const Unit&) const {}
    __device__ __forceinline__ size_t bofs(const Unit&) const { return 0; } };
#ifndef SAME_PM
#define SAME_PM 0
#endif
struct SameOrder { static constexpr bool ROT = false; __device__ __forceinline__ int krot(const Unit&) const { return 0; } int n;
    __device__ __forceinline__ bool next(int i, Unit& u) const { if (i >= n) return false; u.pm = SAME_PM ? (int)(blockIdx.x >> 2) + 64 * i : 0; u.pn = SAME_PM ? (int)(blockIdx.x & 3) : 0; u.ks = 0; return true; }
    __device__ __forceinline__ void a_ready(const Unit&) const {}
    __device__ __forceinline__ void done(const Unit&) const {}
    __device__ __forceinline__ size_t bofs(const Unit&) const { return 0; } };
struct EpiDummy8 { static constexpr bool PERM = EpiSwiglu8::PERM, AFTER_DRAIN = false, IDEM = false; EpiSwiglu8 e;
    __device__ __forceinline__ void operator()(const f32x4 (&acc)[2][2][4][2], const Unit& u, int wr, int wc, int fr, int fq) const { Unit v = u; v.pm = (int)(blockIdx.x >> 1); v.pn = (int)(blockIdx.x & 1); e(acc, v, wr, wc, fr, fq); } };
struct EpiDummyB { static constexpr bool PERM = EpiBf16S::PERM, AFTER_DRAIN = false, IDEM = false; EpiBf16S e;
    __device__ __forceinline__ void operator()(const f32x4 (&acc)[2][2][4][2], const Unit& u, int wr, int wc, int fr, int fq) const { Unit v = u; v.pm = (int)(blockIdx.x >> 2); v.pn = (int)(blockIdx.x & 3); e(acc, v, wr, wc, fr, fq); } };
}

struct SrcMap {
    const float* W0; long long d1; int mode; int N;
    __device__ __forceinline__ const float* col(int nd) const {
        if (mode == 0) return nd < N ? W0 + nd : nullptr;
        if (mode == 1) { if (nd < 1004) return W0 + nd; if (nd < 1008 || nd >= 2548) return nullptr; return W0 + (nd - 4); }
        const int tile = nd >> 8, w = nd & 255, f = tile * 128 + (w & 127); return W0 + (w < 128 ? 0ll : d1) + f;
    }
};
__device__ __forceinline__ void transpose_item(const SrcMap sm, int ldw, int K, bf16* WT, LAS float* scr, int kb, int nb, int lane) {
    const int k0 = 64 * kb, n0 = 32 * nb;
    const float* colp = sm.col(n0 + (lane & 31));
    float v[32];
#pragma unroll
    for (int i = 0; i < 32; ++i) { const int kk = 2 * i + (lane >> 5); v[i] = colp ? __builtin_nontemporal_load(colp + (size_t)(k0 + kk) * ldw) : 0.f; }
#pragma unroll
    for (int i = 0; i < 32; ++i) { const int kk = 2 * i + (lane >> 5); scr[kk * 33 + (lane & 31)] = v[i]; }
    LDS_WAIT();
    const int c = lane & 7;
#pragma unroll
    for (int j = 0; j < 4; ++j) { const int n = (lane >> 3) + 8 * j; const LAS float* s = scr + (8 * c) * 33 + n;
        u32x4 o; o.x = pk2(s[0 * 33], s[1 * 33]); o.y = pk2(s[2 * 33], s[3 * 33]); o.z = pk2(s[4 * 33], s[5 * 33]); o.w = pk2(s[6 * 33], s[7 * 33]);
        *(u32x4*)(WT + (size_t)(n0 + n) * K + k0 + 8 * c) = o; }
    LDS_WAIT();
}
__device__ __forceinline__ unsigned pk4_fp8(float a, float b, float c, float d) { int p = 0; p = __builtin_amdgcn_cvt_pk_fp8_f32(a, b, p, false); p = __builtin_amdgcn_cvt_pk_fp8_f32(c, d, p, true); return (unsigned)p; }
__device__ __forceinline__ float clamp8(float x) { return fminf(fmaxf(x, -448.f), 448.f); }
__device__ __forceinline__ void transpose_item8(const SrcMap sm, int ldw, int K, unsigned char* WT8, float scale, LAS float* scr, int kb, int nb, int lane, int blk = 0) {
    const int k0 = 64 * kb, n0 = 32 * nb;
    const float* colp = sm.col(n0 + (lane & 31));
    float v[32];
#pragma unroll
    for (int i = 0; i < 32; ++i) { const int kk = 2 * i + (lane >> 5); v[i] = colp ? __builtin_nontemporal_load(colp + (size_t)(k0 + kk) * ldw) : 0.f; }
#pragma unroll
    for (int i = 0; i < 32; ++i) { const int kk = 2 * i + (lane >> 5); scr[kk * 33 + (lane & 31)] = v[i]; }
    LDS_WAIT();
    const int n = lane >> 1, h32 = (lane & 1) * 32; const LAS float* s = scr + h32 * 33 + n;
    u32x4 o0, o1;
    o0.x = pk4_fp8(clamp8(s[0 * 33] * scale), clamp8(s[1 * 33] * scale), clamp8(s[2 * 33] * scale), clamp8(s[3 * 33] * scale)); o0.y = pk4_fp8(clamp8(s[4 * 33] * scale), clamp8(s[5 * 33] * scale), clamp8(s[6 * 33] * scale), clamp8(s[7 * 33] * scale));
    o0.z = pk4_fp8(clamp8(s[8 * 33] * scale), clamp8(s[9 * 33] * scale), clamp8(s[10 * 33] * scale), clamp8(s[11 * 33] * scale)); o0.w = pk4_fp8(clamp8(s[12 * 33] * scale), clamp8(s[13 * 33] * scale), clamp8(s[14 * 33] * scale), clamp8(s[15 * 33] * scale));
    o1.x = pk4_fp8(clamp8(s[16 * 33] * scale), clamp8(s[17 * 33] * scale), clamp8(s[18 * 33] * scale), clamp8(s[19 * 33] * scale)); o1.y = pk4_fp8(clamp8(s[20 * 33] * scale), clamp8(s[21 * 33] * scale), clamp8(s[22 * 33] * scale), clamp8(s[23 * 33] * scale));
    o1.z = pk4_fp8(clamp8(s[24 * 33] * scale), clamp8(s[25 * 33] * scale), clamp8(s[26 * 33] * scale), clamp8(s[27 * 33] * scale)); o1.w = pk4_fp8(clamp8(s[28 * 33] * scale), clamp8(s[29 * 33] * scale), clamp8(s[30 * 33] * scale), clamp8(s[31 * 33] * scale));
    const int nr = n0 + n; unsigned char* dst = blk ? WT8 + ((size_t)((nr >> 8) * (K >> 7) + (k0 >> 7)) * 256 + (nr & 255)) * 128 + (k0 & 127) + h32 : WT8 + (size_t)nr * K + k0 + h32;
    *(u32x4*)dst = o0; *(u32x4*)(dst + 16) = o1;
    LDS_WAIT();
}
__device__ __forceinline__ void transpose_load8(const SrcMap sm, int ldw, int kb, int nb, int lane, float (&v)[32]) {
    const int k0 = 64 * kb, n0 = 32 * nb; const float* colp = sm.col(n0 + (lane & 31));
#pragma unroll
    for (int i = 0; i < 32; ++i) { const int kk = 2 * i + (lane >> 5); v[i] = colp ? __builtin_nontemporal_load(colp + (size_t)(k0 + kk) * ldw) : 0.f; }
}
__device__ __forceinline__ void transpose_store8(const float (&v)[32], int K, unsigned char* WT8, float scale, LAS float* scr, int kb, int nb, int lane, int blk) {
    const int k0 = 64 * kb, n0 = 32 * nb;
#pragma unroll
    for (int i = 0; i < 32; ++i) { const int kk = 2 * i + (lane >> 5); scr[kk * 33 + (lane & 31)] = v[i]; }
    LDS_WAIT();
    const int n = lane >> 1, h32 = (lane & 1) * 32; const LAS float* s = scr + h32 * 33 + n;
    u32x4 o0, o1;
    o0.x = pk4_fp8(clamp8(s[0 * 33] * scale), clamp8(s[1 * 33] * scale), clamp8(s[2 * 33] * scale), clamp8(s[3 * 33] * scale)); o0.y = pk4_fp8(clamp8(s[4 * 33] * scale), clamp8(s[5 * 33] * scale), clamp8(s[6 * 33] * scale), clamp8(s[7 * 33] * scale));
    o0.z = pk4_fp8(clamp8(s[8 * 33] * scale), clamp8(s[9 * 33] * scale), clamp8(s[10 * 33] * scale), clamp8(s[11 * 33] * scale)); o0.w = pk4_fp8(clamp8(s[12 * 33] * scale), clamp8(s[13 * 33] * scale), clamp8(s[14 * 33] * scale), clamp8(s[15 * 33] * scale));
    o1.x = pk4_fp8(clamp8(s[16 * 33] * scale), clamp8(s[17 * 33] * scale), clamp8(s[18 * 33] * scale), clamp8(s[19 * 33] * scale)); o1.y = pk4_fp8(clamp8(s[20 * 33] * scale), clamp8(s[21 * 33] * scale), clamp8(s[22 * 33] * scale), clamp8(s[23 * 33] * scale));
    o1.z = pk4_fp8(clamp8(s[24 * 33] * scale), clamp8(s[25 * 33] * scale), clamp8(s[26 * 33] * scale), clamp8(s[27 * 33] * scale)); o1.w = pk4_fp8(clamp8(s[28 * 33] * scale), clamp8(s[29 * 33] * scale), clamp8(s[30 * 33] * scale), clamp8(s[31 * 33] * scale));
    const int nr = n0 + n; unsigned char* dst = blk ? WT8 + ((size_t)((nr >> 8) * (K >> 7) + (k0 >> 7)) * 256 + (nr & 255)) * 128 + (k0 & 127) + h32 : WT8 + (size_t)nr * K + k0 + h32;
    *(u32x4*)dst = o0; *(u32x4*)(dst + 16) = o1;
    LDS_WAIT();
}
__device__ __forceinline__ void transpose_matrix8(const SrcMap sm, int ldw, int K, int Ndst, unsigned char* WT8, float scale, LAS float* scr, int gw, int ngw, int lane, int blk = 0) {
    const int nkb = K / 64, nnb = Ndst / 32, nph = nnb >> 1, npair = nkb * nph;
    for (int pit = gw; pit < npair; pit += ngw) { const int kb = pit / nph, nb = 2 * (pit % nph); float va[32], vb[32];
        transpose_load8(sm, ldw, kb, nb, lane, va); transpose_load8(sm, ldw, kb, nb + 1, lane, vb);
        __builtin_amdgcn_sched_barrier(0);
        transpose_store8(va, K, WT8, scale, scr, kb, nb, lane, blk); transpose_store8(vb, K, WT8, scale, scr, kb, nb + 1, lane, blk); }
}
__device__ __forceinline__ void transpose_matrix(const SrcMap sm, int ldw, int K, int Ndst, bf16* WT, LAS float* scr, int gw, int ngw, int lane) {
    const int nkb = K / 64, nnb = Ndst / 32, nit = nkb * nnb;
    for (int it = gw; it < nit; it += ngw) transpose_item(sm, ldw, K, WT, scr, it / nnb, it % nnb, lane);
}
__device__ __forceinline__ void rms_row_to_bf16(const float* xrow, const float* g, bf16* orow, int lane) {
    const f32x4* xr = (const f32x4*)xrow + lane; const f32x4* gr = (const f32x4*)g + lane;
    f32x4 v[4]; float s = 0.f;
#pragma unroll
    for (int j = 0; j < 4; ++j) { v[j] = xr[64 * j]; s += (v[j].x * v[j].x + v[j].y * v[j].y) + (v[j].z * v[j].z + v[j].w * v[j].w); }
    const float rs = __builtin_amdgcn_rsqf(wave_sum(s) * (1.f / D) + EPS);
    unsigned long long* o8 = (unsigned long long*)orow + lane;
#pragma unroll
    for (int j = 0; j < 4; ++j) { const f32x4 gg = gr[64 * j];
        o8[64 * j] = (unsigned long long)pk2(v[j].x * rs * gg.x, v[j].y * rs * gg.y) | ((unsigned long long)pk2(v[j].z * rs * gg.z, v[j].w * rs * gg.w) << 32); }
}
__device__ __forceinline__ void phase_norm_rows8(const float* X, const float* g, unsigned char* O, float scale, int gw, int ngw, int lane) {
    f32x4 ggv[4];
#pragma unroll
    for (int j = 0; j < 4; ++j) ggv[j] = ((const f32x4*)g + lane)[64 * j];
    int m = gw;
    for (; m + 3 * ngw < T; m += 4 * ngw) {
        f32x4 v[4][4]; float s[4];
#pragma unroll
        for (int q = 0; q < 4; ++q) { const f32x4* xr = (const f32x4*)(X + (size_t)(m + q * ngw) * D) + lane;
#pragma unroll
            for (int j = 0; j < 4; ++j) v[q][j] = xr[64 * j]; }
#pragma unroll
        for (int q = 0; q < 4; ++q) { s[q] = 0.f;
#pragma unroll
            for (int j = 0; j < 4; ++j) s[q] += (v[q][j].x * v[q][j].x + v[q][j].y * v[q][j].y) + (v[q][j].z * v[q][j].z + v[q][j].w * v[q][j].w); }
#pragma unroll
        for (int q = 0; q < 4; ++q) { const float rs = scale * __builtin_amdgcn_rsqf(wave_sum(s[q]) * (1.f / D) + EPS); unsigned* o4 = (unsigned*)(O + (size_t)(m + q * ngw) * D) + lane;
#pragma unroll
            for (int j = 0; j < 4; ++j) { const f32x4 gg = ggv[j]; o4[64 * j] = pk4_fp8(clamp8(v[q][j].x * rs * gg.x), clamp8(v[q][j].y * rs * gg.y), clamp8(v[q][j].z * rs * gg.z), clamp8(v[q][j].w * rs * gg.w)); } }
    }
    for (; m < T; m += ngw) {
        const f32x4* xr = (const f32x4*)(X + (size_t)m * D) + lane;
        f32x4 v[4]; float s = 0.f;
#pragma unroll
        for (int j = 0; j < 4; ++j) { v[j] = xr[64 * j]; s += (v[j].x * v[j].x + v[j].y * v[j].y) + (v[j].z * v[j].z + v[j].w * v[j].w); }
        const float rs = scale * __builtin_amdgcn_rsqf(wave_sum(s) * (1.f / D) + EPS);
        unsigned* o4 = (unsigned*)(O + (size_t)m * D) + lane;
#pragma unroll
        for (int j = 0; j < 4; ++j) { const f32x4 gg = ggv[j]; o4[64 * j] = pk4_fp8(clamp8(v[j].x * rs * gg.x), clamp8(v[j].y * rs * gg.y), clamp8(v[j].z * rs * gg.z), clamp8(v[j].w * rs * gg.w)); }
    }
}
__device__ __forceinline__ void phase_add_norm_rows(float* X, const bf16* Dl, const float* g, bf16* O, int gw, int ngw, int lane, unsigned char* O8 = nullptr) {
    f32x4 ggv[4];
#pragma unroll
    for (int j = 0; j < 4; ++j) ggv[j] = ((const f32x4*)g + lane)[64 * j];
    constexpr int NR = 2;
    for (int m = gw; m < T; m += NR * ngw) {
        int mr[NR]; bool ok[NR];
#pragma unroll
        for (int q = 0; q < NR; ++q) { ok[q] = m + q * ngw < T; mr[q] = ok[q] ? m + q * ngw : m; }
        f32x4 v[NR][4]; u32x2 d[NR][4];
#pragma unroll
        for (int q = 0; q < NR; ++q) { const f32x4* xr = (const f32x4*)(X + (size_t)mr[q] * D) + lane; const u32x2* dr = (const u32x2*)(Dl + (size_t)mr[q] * D) + lane;
#pragma unroll
            for (int j = 0; j < 4; ++j) { v[q][j] = xr[64 * j]; d[q][j] = dr[64 * j]; } }
#pragma unroll
        for (int q = 0; q < NR; ++q) { float s = 0.f;
#pragma unroll
            for (int j = 0; j < 4; ++j) { v[q][j].x += lo_bf(d[q][j].x); v[q][j].y += hi_bf(d[q][j].x); v[q][j].z += lo_bf(d[q][j].y); v[q][j].w += hi_bf(d[q][j].y);
                s += (v[q][j].x * v[q][j].x + v[q][j].y * v[q][j].y) + (v[q][j].z * v[q][j].z + v[q][j].w * v[q][j].w); }
            const float rs = __builtin_amdgcn_rsqf(wave_sum(s) * (1.f / D) + EPS);
            if (ok[q]) { f32x4* xo = (f32x4*)(X + (size_t)mr[q] * D) + lane; unsigned long long* o8 = (unsigned long long*)(O + (size_t)mr[q] * D) + lane;
#pragma unroll
                for (int j = 0; j < 4; ++j) { const f32x4 gg = ggv[j]; xo[64 * j] = v[q][j];
                    o8[64 * j] = (unsigned long long)pk2(v[q][j].x * rs * gg.x, v[q][j].y * rs * gg.y) | ((unsigned long long)pk2(v[q][j].z * rs * gg.z, v[q][j].w * rs * gg.w) << 32);
                    if (INPROJ_SPLIT) { const float r8 = rs * F8_H; ((unsigned*)(O8 + (size_t)mr[q] * D) + lane)[64 * j] = pk4_fp8(clamp8(v[q][j].x * r8 * gg.x), clamp8(v[q][j].y * r8 * gg.y), clamp8(v[q][j].z * r8 * gg.z), clamp8(v[q][j].w * r8 * gg.w)); } } }
        }
    }
}
__device__ __forceinline__ void phase_norm_rows(const float* X, const float* g, bf16* O, int gw, int ngw, int lane, unsigned char* O8 = nullptr, int row0 = 0, int row1 = T) {
    int m = row0 + gw;
    f32x4 ggv[4];
#pragma unroll
    for (int j = 0; j < 4; ++j) ggv[j] = ((const f32x4*)g + lane)[64 * j];
    for (; m + 3 * ngw < row1; m += 4 * ngw) {
        f32x4 v[4][4]; float s[4];
#pragma unroll
        for (int q = 0; q < 4; ++q) { const f32x4* xr = (const f32x4*)(X + (size_t)(m + q * ngw) * D) + lane;
#pragma unroll
            for (int j = 0; j < 4; ++j) v[q][j] = xr[64 * j]; }
#pragma unroll
        for (int q = 0; q < 4; ++q) { s[q] = 0.f;
#pragma unroll
            for (int j = 0; j < 4; ++j) s[q] += (v[q][j].x * v[q][j].x + v[q][j].y * v[q][j].y) + (v[q][j].z * v[q][j].z + v[q][j].w * v[q][j].w); }
#pragma unroll
        for (int q = 0; q < 4; ++q) { const float rs = __builtin_amdgcn_rsqf(wave_sum(s[q]) * (1.f / D) + EPS);
            unsigned long long* o8 = (unsigned long long*)(O + (size_t)(m + q * ngw) * D) + lane;
#pragma unroll
            for (int j = 0; j < 4; ++j) { const f32x4 gg = ggv[j];
                o8[64 * j] = (unsigned long long)pk2(v[q][j].x * rs * gg.x, v[q][j].y * rs * gg.y) | ((unsigned long long)pk2(v[q][j].z * rs * gg.z, v[q][j].w * rs * gg.w) << 32);
                if (INPROJ_SPLIT) { const float r8 = rs * F8_H; ((unsigned*)(O8 + (size_t)(m + q * ngw) * D) + lane)[64 * j] = pk4_fp8(clamp8(v[q][j].x * r8 * gg.x), clamp8(v[q][j].y * r8 * gg.y), clamp8(v[q][j].z * r8 * gg.z), clamp8(v[q][j].w * r8 * gg.w)); } } }
    }
    for (; m < row1; m += ngw) rms_row_to_bf16(X + (size_t)m * D, g, O + (size_t)m * D, lane);
}
__device__ __forceinline__ void phase_final_norm(float* X, const float* g, int gw, int ngw, int lane) {
    for (int m = gw; m < T; m += ngw) {
        f32x4* xr = (f32x4*)(X + (size_t)m * D) + lane; const f32x4* gr = (const f32x4*)g + lane;
        f32x4 v[4]; float s = 0.f;
#pragma unroll
        for (int j = 0; j < 4; ++j) { v[j] = xr[64 * j]; s += (v[j].x * v[j].x + v[j].y * v[j].y) + (v[j].z * v[j].z + v[j].w * v[j].w); }
        const float rs = __builtin_amdgcn_rsqf(wave_sum(s) * (1.f / D) + EPS);
#pragma unroll
        for (int j = 0; j < 4; ++j) xr[64 * j] = v[j] * rs * gr[64 * j];
    }
}

__device__ __forceinline__ void phase_prep_weights(const Args& A, LAS unsigned char* lds, int gw, int ngw, int wave, int lane) {
    unsigned char* ws = A.ws;
    LAS float* scr = (LAS float*)(lds + wave * 16384);
    for (int l = 0; l < DEPTH; ++l) {
#if INPROJ_F8
        transpose_matrix8(SrcMap{INF(I_W_IN) + (size_t)l * D * IN_COLS, 0, 1, IN_COLS}, IN_COLS, D, INC, ws + WS_WIN + (size_t)l * INC * D, F8_WGU, scr, gw, ngw, lane);
#else
        transpose_matrix(SrcMap{INF(I_W_IN) + (size_t)l * D * IN_COLS, 0, 1, IN_COLS}, IN_COLS, D, INC, (bf16*)(ws + WS_WIN) + (size_t)l * INC * D, scr, gw, ngw, lane);
        if (INPROJ_SPLIT) transpose_matrix8(SrcMap{INF(I_W_IN) + (size_t)l * D * IN_COLS, 0, 1, IN_COLS}, IN_COLS, D, 256 * INPROJ_SPLIT, ws + WS_WIN8 + (size_t)l * 256 * INPROJ_SPLIT * D, F8_WGU, scr, gw, ngw, lane);
#endif
        transpose_matrix(SrcMap{INF(I_W_OUT) + (size_t)l * D * D, 0, 0, D}, D, D, D, (bf16*)(ws + WS_WOUT) + (size_t)l * D * D, scr, gw, ngw, lane);
        transpose_matrix(SrcMap{INF(I_MLA_WUQ) + (size_t)l * 192 * 384, 0, 0, 384}, 384, 192, 384, (bf16*)(ws + WS_WUQ) + (size_t)l * 384 * 192, scr, gw, ngw, lane);
        transpose_matrix(SrcMap{INF(I_MLA_WUKV) + (size_t)l * 128 * 512, 0, 0, 512}, 512, 128, 512, (bf16*)(ws + WS_WUKV) + (size_t)l * 512 * 128, scr, gw, ngw, lane);
        for (int kv = 0; kv < 2; ++kv)
            transpose_matrix(SrcMap{INF(I_NSA_WCMP) + (size_t)(l * 2 + kv) * 2048 * 64, 0, 0, 64}, 64, 2048, 64, (bf16*)(ws + WS_WCT) + (size_t)(l * 2 + kv) * 64 * 2048, scr, gw, ngw, lane);
        for (int gn = 0; gn < 8; ++gn)
            transpose_matrix(SrcMap{INF(I_LRU_WG) + (size_t)(l * 8 + gn) * 64 * 64, 0, 0, 64}, 64, 64, 64, (bf16*)(ws + WS_WGT) + (size_t)(l * 8 + gn) * 64 * 64, scr, gw, ngw, lane);
    }
    transpose_matrix8(SrcMap{INF(I_FFN_WG), (long long)(INF(I_FFN_WU) - INF(I_FFN_WG)), 2, DFF}, DFF, D, 2 * DFF, ws + WS_FGU, F8_WGU, scr, gw, ngw, lane);
    transpose_matrix8(SrcMap{INF(I_FFN_WD), 0, 0, D}, D, DFF, D, ws + WS_FD, F8_WD, scr, gw, ngw, lane, 1);
    if (gw < 256) { const int m4 = gw >> 6, o = gw & 63; const float* pe = INF(I_NSA_PE) + (size_t)m4 * 2048; const float* w = INF(I_NSA_WCMP) + (size_t)m4 * 2048 * 64 + o; float s = 0.f;
#pragma unroll 8
        for (int k = lane; k < 2048; k += 64) s += pe[k] * w[(size_t)k * 64];
        s = wave_sum(s);
        if (lane == 0) ((float*)(ws + WS_BIASC))[m4 * 64 + o] = s; }
    { const int* pos = (const int*)A.in[I_POS]; float* cm = (float*)(ws + WS_ROPEM); float* sm_ = cm + SEQ * 16; float* cn = (float*)(ws + WS_ROPEN); float* sn = cn + SEQ * 8;
      for (int i = gw * 64 + lane; i < SEQ * 16; i += ngw * 64) { const int s = i >> 4, j = i & 15; const float inv = powf(500000.0f, -(float)(2 * j) / 32.0f); const float ang = (float)pos[s] * inv; cm[i] = cosf(ang); sm_[i] = sinf(ang); }
      for (int i = gw * 64 + lane; i < SEQ * 8; i += ngw * 64) { const int s = i >> 3, j = i & 7; const float inv = powf(500000.0f, -(float)(2 * j) / 16.0f); const float ang = (float)pos[s] * inv; cn[i] = cosf(ang); sn[i] = sinf(ang); } }
}

template <int NROWS, int NCH16> __device__ __forceinline__ void load_rows_lds(const bf16* ub  , int s_first, LAS unsigned char* dst, int tid) {
    constexpr int NCHUNK = NROWS * NCH16, PER = (NCHUNK + NTHR - 1) / NTHR;
    u32x4 r[PER];
#pragma unroll
    for (int i = 0; i < PER; ++i) { int ci = tid + i * NTHR; ci = ci < NCHUNK ? ci : NCHUNK - 1; const int row = ci / NCH16, ch = ci % NCH16, sr = s_first + row;
        r[i] = *(const u32x4*)(ub + (size_t)(sr < 0 ? 0 : sr) * INC + 8 * ch); if (sr < 0) r[i] = (u32x4){0u, 0u, 0u, 0u}; }
#pragma unroll
    for (int i = 0; i < PER; ++i) { const int ci = tid + i * NTHR; if (ci < NCHUNK) { const int row = ci / NCH16, ch = ci % NCH16; *(LAS u32x4*)(dst + row * (16 * NCH16 + 16) + 16 * ch) = r[i]; } }
}
template <int NROWS, int NCH16> __device__ __forceinline__ void load_rows_regs(const bf16* ub, int s_first, int tid, u32x4 (&r)[(NROWS * NCH16 + NTHR - 1) / NTHR]) {
    constexpr int NCHUNK = NROWS * NCH16, PER = (NCHUNK + NTHR - 1) / NTHR;
#pragma unroll
    for (int i = 0; i < PER; ++i) { int ci = tid + i * NTHR; ci = ci < NCHUNK ? ci : NCHUNK - 1; const int row = ci / NCH16, ch = ci % NCH16, sr = s_first + row;
        r[i] = *(const u32x4*)(ub + (size_t)(sr < 0 ? 0 : sr) * INC + 8 * ch); if (sr < 0) r[i] = (u32x4){0u, 0u, 0u, 0u}; }
}
template <int NROWS, int NCH16> __device__ __forceinline__ void store_rows_lds(const u32x4 (&r)[(NROWS * NCH16 + NTHR - 1) / NTHR], LAS unsigned char* dst, int tid) {
    constexpr int NCHUNK = NROWS * NCH16, PER = (NCHUNK + NTHR - 1) / NTHR;
#pragma unroll
    for (int i = 0; i < PER; ++i) { const int ci = tid + i * NTHR; if (ci < NCHUNK) { const int row = ci / NCH16, ch = ci % NCH16; *(LAS u32x4*)(dst + row * (16 * NCH16 + 16) + 16 * ch) = r[i]; } }
}
__device__ __forceinline__ void lru_local_tile(const Args& A, int l, int tile, LAS unsigned char* lds) {
    unsigned char* ws = A.ws;
    int tid = threadIdx.x; asm volatile("" : "+v"(tid)); const int lane = tid & 63, wid = __builtin_amdgcn_readfirstlane(tid >> 6);
    const int tok0 = tile * 64, b = tok0 / SEQ, s0 = tok0 % SEQ;
    LAS float* XF = (LAS float*)lds; LAS float* AS = (LAS float*)(lds + 32768); LAS bf16* XH = (LAS bf16*)(lds + 65536);
    const bf16* U = (const bf16*)(ws + WS_U);
    const int c = tid & 255, tg = tid >> 8;
    const float* cw = INF(I_LRU_CW) + (size_t)l * 4 * 256; const float cw0 = cw[c], cw1 = cw[256 + c], cw2 = cw[512 + c], cw3 = cw[768 + c], cb = INF(I_LRU_CB)[l * 256 + c];
    float h = 0.f, P = 1.f;
    bf16x8 wg0[4], wg1[4]; float bg0, bg1, sp;
    { const int n = wid & 3, db = wid >> 2, r32 = lane & 31, hi = lane >> 5; const int d = 64 * n + 32 * db + r32;
      const bf16* w0 = (const bf16*)(ws + WS_WGT) + ((size_t)((l * 2 + 0) * 4 + n) * 64 + 32 * db + r32) * 64 + hi * 8;
      const bf16* w1 = (const bf16*)(ws + WS_WGT) + ((size_t)((l * 2 + 1) * 4 + n) * 64 + 32 * db + r32) * 64 + hi * 8;
#pragma unroll
      for (int ks = 0; ks < 4; ++ks) { wg0[ks] = *(const bf16x8*)(w0 + 16 * ks); wg1[ks] = *(const bf16x8*)(w1 + 16 * ks); }
      bg0 = INF(I_LRU_BG)[(l * 2 + 0) * 256 + d]; bg1 = INF(I_LRU_BG)[(l * 2 + 1) * 256 + d];
      const float lam = INF(I_LRU_LAM)[l * 256 + d]; sp = log1pf(__expf(-lam)); }
    LAS unsigned char* RAW = lds + 82432;
    load_rows_lds<67, 32>(U + (size_t)(b * SEQ) * INC + U_LX, s0 - 3, RAW, tid);
    WG_BAR();
    for (int hh = 0; hh < 2; ++hh) {
        {
            const LAS bf16* rp = (const LAS bf16*)(RAW + (32 * hh + 16 * tg) * 528) + c;
            float xm3 = bf2f(rp[0]), xm2 = bf2f(rp[264]), xm1 = bf2f(rp[528]);
#pragma unroll
            for (int i = 0; i < 16; ++i) { const float x0 = bf2f(rp[(i + 3) * 264]); const float v = cb + cw0 * xm3 + cw1 * xm2 + cw2 * xm1 + cw3 * x0;
                XF[(16 * tg + i) * 256 + c] = v; XH[(16 * tg + i) * 264 + c] = (bf16)f2bf(v); xm3 = xm2; xm2 = xm1; xm1 = x0; }
        }
        WG_BAR();
        {
            const int n = wid & 3, db = wid >> 2, r32 = lane & 31, hi = lane >> 5;
            f32x16 g0 = {}, g1 = {};
#pragma unroll
            for (int ks = 0; ks < 4; ++ks) { const bf16x8 a = *(const LAS bf16x8*)(XH + r32 * 264 + 64 * n + 16 * ks + 8 * hi);
                g0 = MFMA32(a, wg0[ks], g0); g1 = MFMA32(a, wg1[ks], g1); }
            const int d = 64 * n + 32 * db + r32;
#pragma unroll
            for (int r = 0; r < 16; ++r) { const int t = crow(r, hi); const float rr = sigmoidf_(g0[r] + bg0), ii = sigmoidf_(g1[r] + bg1);
                const float la = -8.0f * rr * sp; const float a_ = __expf(la); const float x2 = 2.0f * la;
                const float om = x2 > -0.02f ? -x2 * (1.0f + 0.5f * x2 * (1.0f + x2 * (1.0f / 3.0f))) : 1.0f - a_ * a_;
                const float bb = __builtin_amdgcn_sqrtf(fmaxf(om, 0.f)) * ii * XF[t * 256 + d];
                AS[t * 256 + d] = a_; XF[t * 256 + d] = bb; }
        }
        WG_BAR();
        if (tid < 256) {
            bf16* HL = (bf16*)(ws + WS_LHL) + (size_t)(tok0 + 32 * hh) * 256 + c; bf16* PC = (bf16*)(ws + WS_LPC) + (size_t)(tok0 + 32 * hh) * 256 + c;
#pragma unroll 8
            for (int t = 0; t < 32; ++t) { const float a_ = AS[t * 256 + c], b_ = XF[t * 256 + c]; h = a_ * h + b_; P *= a_; HL[(size_t)t * 256] = (bf16)f2bf(h); PC[(size_t)t * 256] = (bf16)f2bf(P); }
        }
        WG_BAR();
    }
    if (tid < 256) { ((float*)(ws + WS_LACH))[tile * 256 + c] = P; ((float*)(ws + WS_LHCH))[tile * 256 + c] = h; }
}
__device__ __forceinline__ void lru_carry_unit(const Args& A, int b) {
    unsigned char* ws = A.ws; const int c = threadIdx.x;
    if (c < 256) { const float* ach = (const float*)(ws + WS_LACH) + (size_t)b * 128 * 256 + c; const float* hch = (const float*)(ws + WS_LHCH) + (size_t)b * 128 * 256 + c; float* cin = (float*)(ws + WS_LCIN) + (size_t)b * 128 * 256 + c;
        float carry = 0.f;
        for (int c0 = 0; c0 < 128; c0 += 16) { float av[16], hv[16];
#pragma unroll
            for (int j = 0; j < 16; ++j) { av[j] = ach[(c0 + j) * 256]; hv[j] = hch[(c0 + j) * 256]; }
            __builtin_amdgcn_sched_barrier(0);
#pragma unroll
            for (int j = 0; j < 16; ++j) { cin[(c0 + j) * 256] = carry; carry = av[j] * carry + hv[j]; } } }
}
__device__ __forceinline__ float gelu_tanh(float x) { const float u = 0.7978845608028654f * (x + 0.044715f * x * x * x); return x * __builtin_amdgcn_rcpf(1.0f + __expf(-2.0f * u)); }
__device__ __forceinline__ void lru_final_tile(const Args& A, int l, int tile) {
    unsigned char* ws = A.ws; int tid = threadIdx.x; asm volatile("" : "+v"(tid)); const int tt = tid >> 3, sub = tid & 7; const int tok = tile * 64 + tt, c0 = sub * 32;
    const u32x4* hl = (const u32x4*)((const bf16*)(ws + WS_LHL) + (size_t)tok * 256 + c0); const u32x4* pc = (const u32x4*)((const bf16*)(ws + WS_LPC) + (size_t)tok * 256 + c0);
    const f32x4* cin = (const f32x4*)((const float*)(ws + WS_LCIN) + (size_t)tile * 256 + c0); const u32x4* gb = (const u32x4*)((const bf16*)(ws + WS_U) + (size_t)tok * INC + U_LG + c0);
    const f32x4* gn = (const f32x4*)(INF(I_GNORM) + (size_t)(l * 4 + 2) * 256 + c0);
    float o[32]; float ss = 0.f;
    f32x4 gnv[8];
#pragma unroll
    for (int q = 0; q < 8; ++q) gnv[q] = gn[q];
#pragma unroll
    for (int q = 0; q < 4; ++q) { const u32x4 hv = hl[q], pv = pc[q], gv = gb[q]; const f32x4 c0v = cin[2 * q], c1v = cin[2 * q + 1];
        const unsigned hw[4] = {hv.x, hv.y, hv.z, hv.w}, pw[4] = {pv.x, pv.y, pv.z, pv.w}, gw_[4] = {gv.x, gv.y, gv.z, gv.w}; const float cc[8] = {c0v.x, c0v.y, c0v.z, c0v.w, c1v.x, c1v.y, c1v.z, c1v.w};
#pragma unroll
        for (int j = 0; j < 4; ++j) { const float h0 = lo_bf(hw[j]) + lo_bf(pw[j]) * cc[2 * j], h1 = hi_bf(hw[j]) + hi_bf(pw[j]) * cc[2 * j + 1];
            const float v0 = h0 * gelu_tanh(lo_bf(gw_[j])), v1 = h1 * gelu_tanh(hi_bf(gw_[j])); o[8 * q + 2 * j] = v0; o[8 * q + 2 * j + 1] = v1; ss += v0 * v0 + v1 * v1; } }
    ss += __shfl_xor(ss, 1); ss += __shfl_xor(ss, 2); ss += __shfl_xor(ss, 4);
    const float rs = __builtin_amdgcn_rsqf(ss * (1.f / 256.f) + EPS);
    u32x4* yo = (u32x4*)((bf16*)(ws + WS_Y) + (size_t)tok * D + 512 + c0);
#pragma unroll
    for (int q = 0; q < 4; ++q) { const f32x4 g0 = gnv[2 * q], g1 = gnv[2 * q + 1]; u32x4 w;
        w.x = pk2(o[8 * q + 0] * rs * g0.x, o[8 * q + 1] * rs * g0.y); w.y = pk2(o[8 * q + 2] * rs * g0.z, o[8 * q + 3] * rs * g0.w);
        w.z = pk2(o[8 * q + 4] * rs * g1.x, o[8 * q + 5] * rs * g1.y); w.w = pk2(o[8 * q + 6] * rs * g1.z, o[8 * q + 7] * rs * g1.w); yo[q] = w; }
}

struct ConvState { float xm3, xm2, xm1; };
__device__ __forceinline__ void conv_init(ConvState& st, const bf16* up, int s) {
    st.xm3 = (s - 3 >= 0) ? bf2f(up[(size_t)(s - 3) * INC]) : 0.f; st.xm2 = (s - 2 >= 0) ? bf2f(up[(size_t)(s - 2) * INC]) : 0.f; st.xm1 = (s - 1 >= 0) ? bf2f(up[(size_t)(s - 1) * INC]) : 0.f; }
__device__ __forceinline__ float conv_step(ConvState& st, const bf16* up, int s, float w0, float w1, float w2, float w3, float cb) {
    const float x0 = bf2f(up[(size_t)s * INC]); const float v = cb + w0 * st.xm3 + w1 * st.xm2 + w2 * st.xm1 + w3 * x0; st.xm3 = st.xm2; st.xm2 = st.xm1; st.xm1 = x0; return v; }
template <int NT> __device__ __forceinline__ void conv_load(float (&x)[NT + 3], const bf16* up, int s) {
#pragma unroll
    for (int i = 0; i < NT + 3; ++i) { const int t = s - 3 + i; const unsigned short r = up[(size_t)(t < 0 ? 0 : t) * INC]; x[i] = t < 0 ? 0.f : bf2f(r); }
}
__device__ __forceinline__ float siluf_(float v) { return v * __builtin_amdgcn_rcpf(1.0f + __expf(-v)); }
__device__ __forceinline__ float softplusf_(float x) { return fmaxf(x, 0.f) + log1pf(__expf(-fabsf(x))); }
__device__ __forceinline__ int perm16pos(int l) { return (l & ~15) | (((l >> 2) & 1) << 3) | (((l >> 3) & 1) << 2) | (l & 3); }
__device__ __forceinline__ void ssd_dt_scan(const Args& A, int l, int h, const bf16* Ub, int s0, int lane, float& dt0, float& dt1, float& acs0, float& acs1, float& Ttot) {
    const float dtb = INF(I_SSD_DTB)[l * 4 + h], Ah = -__expf(INF(I_SSD_ALOG)[l * 4 + h]);
    const float r0 = bf2f(Ub[(size_t)(s0 + 2 * lane) * INC + U_SDT + h]), r1 = bf2f(Ub[(size_t)(s0 + 2 * lane + 1) * INC + U_SDT + h]);
    dt0 = softplusf_(r0 + dtb); dt1 = softplusf_(r1 + dtb);
    const float dA0 = dt0 * Ah, dA1 = dt1 * Ah, s = dA0 + dA1; float incl = s;
#pragma unroll
    for (int o = 1; o < 64; o <<= 1) { const float t = __shfl_up(incl, o); if (lane >= o) incl += t; }
    acs0 = incl - s + dA0; acs1 = incl; Ttot = __shfl(incl, 63);
}
__device__ __forceinline__ void ssd_state_unit(const Args& A, int l, int unit, LAS unsigned char* lds) {
    unsigned char* ws = A.ws;
    int tid = threadIdx.x; asm volatile("" : "+v"(tid)); const int lane = tid & 63, wid = __builtin_amdgcn_readfirstlane(tid >> 6), r32 = lane & 31, hi = lane >> 5;
    const int g = unit & 1, bc = unit >> 1, b = bc >> 6, chunk = bc & 63, s0 = chunk * 128;
    LAS bf16* XdT = (LAS bf16*)lds; LAS bf16* BT = (LAS bf16*)(lds + 34816); LAS float* WL = (LAS float*)(lds + 69632);
    const bf16* Ub = (const bf16*)(ws + WS_U) + (size_t)(b * SEQ) * INC;
    LAS unsigned char* RAWX = lds + 71680; LAS unsigned char* RAWB = lds + 107520;
    load_rows_lds<131, 16>(Ub + U_SX + g * 128, s0 - 3, RAWX, tid);
    load_rows_lds<131, 16>(Ub + U_SB + g * 128, s0 - 3, RAWB, tid);
    if (wid < 2) { float dt0, dt1, a0, a1, Tt; ssd_dt_scan(A, l, 2 * g + wid, Ub, s0, lane, dt0, dt1, a0, a1, Tt);
        WL[wid * 128 + 2 * lane] = dt0 * __expf(Tt - a0); WL[wid * 128 + 2 * lane + 1] = dt1 * __expf(Tt - a1);
        if (lane == 0) ((float*)(ws + WS_STT))[bc * 4 + 2 * g + wid] = Tt; }
    const int chn = tid & 255, tg = tid >> 8; const bool isx = chn < 128; const int cc = chn & 127, ch768 = isx ? g * 128 + cc : 256 + g * 128 + cc;
    const float* cw = INF(I_SSD_CW) + (size_t)l * 4 * 768 + ch768; const float w0 = cw[0], w1 = cw[768], w2 = cw[1536], w3 = cw[2304], cb = INF(I_SSD_CB)[l * 768 + ch768];
    WG_BAR();
    {
        LAS bf16* dst = isx ? XdT + cc * 136 : BT + cc * 136; const LAS float* wl = WL + ((chn >> 6) & 1) * 128;
        const LAS bf16* rp = (const LAS bf16*)((isx ? RAWX : RAWB) + (64 * tg) * 272) + cc;
        float xm3 = bf2f(rp[0]), xm2 = bf2f(rp[136]), xm1 = bf2f(rp[272]);
        for (int i8 = 0; i8 < 8; ++i8) { float v[8];
#pragma unroll
            for (int j = 0; j < 8; ++j) { const int q = 8 * i8 + j, tt = 64 * tg + q; const float x0 = bf2f(rp[(q + 3) * 136]); float x = siluf_(cb + w0 * xm3 + w1 * xm2 + w2 * xm1 + w3 * x0); xm3 = xm2; xm2 = xm1; xm1 = x0; if (isx) x *= wl[tt]; v[j] = x; }
            u32x4 o; o.x = pk2(v[0], v[1]); o.y = pk2(v[2], v[3]); o.z = pk2(v[4], v[5]); o.w = pk2(v[6], v[7]);
            *(LAS u32x4*)(dst + 64 * tg + 8 * i8) = o; }
    }
    WG_BAR();
    {   const int hh = wid >> 2, nb = wid & 3; f32x16 acc[2] = {};
#pragma unroll
        for (int ks = 0; ks < 8; ++ks) { const bf16x8 bf = *(const LAS bf16x8*)(BT + (32 * nb + r32) * 136 + 16 * ks + 8 * hi);
#pragma unroll
            for (int pb = 0; pb < 2; ++pb) { const bf16x8 af = *(const LAS bf16x8*)(XdT + (hh * 64 + 32 * pb + r32) * 136 + 16 * ks + 8 * hi); acc[pb] = MFMA32(af, bf, acc[pb]); } }
        float* S = (float*)(ws + WS_SST) + (size_t)(bc * 4 + 2 * g + hh) * 8192 + 32 * nb + r32;
#pragma unroll
        for (int pb = 0; pb < 2; ++pb)
#pragma unroll
            for (int r = 0; r < 16; ++r) S[(size_t)(32 * pb + crow(r, hi)) * 128] = acc[pb][r];
    }
    WG_BAR();
}
__device__ __forceinline__ void ssd_prop_unit(const Args& A, int unit) {
    unsigned char* ws = A.ws; const int bh = unit >> 2, sl = unit & 3, b = bh >> 2, h = bh & 3;
    const size_t eoff = (size_t)(b * 64 * 4 + h) * 8192 + sl * 2048 + threadIdx.x * 4;
    const float* base = (const float*)(ws + WS_SST) + eoff; float* hout = (float*)(ws + WS_SHIN) + eoff; const float* tt = (const float*)(ws + WS_STT) + b * 64 * 4 + h;
    f32x4 carry = {0.f, 0.f, 0.f, 0.f};
    f32x4 sv[8], nsv[8]; float tv[8], ntv[8];
#pragma unroll
    for (int j = 0; j < 8; ++j) { sv[j] = *(const f32x4*)(base + (size_t)j * 4 * 8192); tv[j] = tt[j * 4]; }
#pragma unroll
    for (int z0 = 0; z0 < 64; z0 += 8) {
        if (z0 + 8 < 64) {
#pragma unroll
            for (int j = 0; j < 8; ++j) { nsv[j] = *(const f32x4*)(base + (size_t)(z0 + 8 + j) * 4 * 8192); ntv[j] = tt[(z0 + 8 + j) * 4]; } }
        __builtin_amdgcn_sched_barrier(0);
#pragma unroll
        for (int j = 0; j < 8; ++j) { *(f32x4*)(hout + (size_t)(z0 + j) * 4 * 8192) = carry; carry = carry * __expf(tv[j]) + sv[j]; }
        __builtin_amdgcn_sched_barrier(0);
#pragma unroll
        for (int j = 0; j < 8; ++j) { sv[j] = nsv[j]; tv[j] = ntv[j]; }
    }
}
__device__ __forceinline__ void ssd_final_unit(const Args& A, int l, int bc, LAS unsigned char* lds) {
    unsigned char* ws = A.ws;
    int tid = threadIdx.x; asm volatile("" : "+v"(tid)); const int lane = tid & 63, wid = __builtin_amdgcn_readfirstlane(tid >> 6), r32 = lane & 31, hi = lane >> 5;
    const int b = bc >> 6, chunk = bc & 63, s0 = chunk * 128;
    LAS bf16* Bs = (LAS bf16*)lds; LAS bf16* Cs = (LAS bf16*)(lds + 34816); LAS bf16* XT = (LAS bf16*)(lds + 69632); LAS bf16* Hs = (LAS bf16*)(lds + 104448);
    LAS float* ACS = (LAS float*)(lds + 140288); LAS float* DTV = ACS + 256; LAS float* SSQ = DTV + 256;
    const bf16* Ub = (const bf16*)(ws + WS_U) + (size_t)(b * SEQ) * INC;
    const int lb = wid & 3, hh = wid >> 2, lq = 32 * lb + r32;
    f32x16 yk[2][2];
#pragma unroll
    for (int g = 0; g < 2; ++g) {
#ifndef RS_DT
#define RS_DT 1
#endif
        for (int rd_ = 0; rd_ < RS_DT; ++rd_)
        if (wid < 2) { float dt0, dt1, a0, a1, Tt; ssd_dt_scan(A, l, 2 * g + wid, Ub, s0, lane, dt0, dt1, a0, a1, Tt);
            ACS[wid * 128 + 2 * lane] = a0; ACS[wid * 128 + 2 * lane + 1] = a1; DTV[wid * 128 + 2 * lane] = dt0; DTV[wid * 128 + 2 * lane + 1] = dt1; }
#ifndef RS_CONV
#define RS_CONV 1
#endif
#ifndef RS_MM
#define RS_MM 1
#endif
        for (int rc_ = 0; rc_ < RS_CONV; ++rc_) {
        u32x4 rimg[5];
        load_rows_regs<131, 16>(Ub + U_SX + g * 128, s0 - 3, tid, rimg);
#pragma unroll 1
        for (int kind = 0; kind < 3; ++kind) {
            LAS unsigned char* RAW = lds + 104448;
            const int cc = tid & 127, tq = tid >> 7, ch768 = kind * 256 + g * 128 + cc;
            const float* cw = INF(I_SSD_CW) + (size_t)l * 4 * 768 + ch768; const float w0 = cw[0], w1 = cw[768], w2 = cw[1536], w3 = cw[2304], cb = INF(I_SSD_CB)[l * 768 + ch768];
            store_rows_lds<131, 16>(rimg, RAW, tid);
            WG_BAR();
            load_rows_regs<131, 16>(Ub + U_SX + (kind < 2 ? kind + 1 : 2) * 256 + g * 128, s0 - 3, tid, rimg);
            const LAS bf16* rp = (const LAS bf16*)(RAW + (32 * tq) * 272) + cc;
            float xm3 = bf2f(rp[0]), xm2 = bf2f(rp[136]), xm1 = bf2f(rp[272]);
#pragma unroll
            for (int half = 0; half < 2; ++half) { float v[16]; const int t0 = 32 * tq + 16 * half;
#pragma unroll
                for (int j = 0; j < 16; ++j) { const float x0 = bf2f(rp[(16 * half + j + 3) * 136]); v[j] = siluf_(cb + w0 * xm3 + w1 * xm2 + w2 * xm1 + w3 * x0); xm3 = xm2; xm2 = xm1; xm1 = x0; }
                if (kind == 0) { u32x4 o0, o1; o0.x = pk2(v[0], v[1]); o0.y = pk2(v[2], v[3]); o0.z = pk2(v[8], v[9]); o0.w = pk2(v[10], v[11]);
                    o1.x = pk2(v[4], v[5]); o1.y = pk2(v[6], v[7]); o1.z = pk2(v[12], v[13]); o1.w = pk2(v[14], v[15]);
                    *(LAS u32x4*)(XT + cc * 136 + t0) = o0; *(LAS u32x4*)(XT + cc * 136 + t0 + 8) = o1; }
                else { LAS bf16* dst = (kind == 1 ? Bs : Cs) + t0 * 136 + cc;
#pragma unroll
                    for (int j = 0; j < 16; ++j) dst[j * 136] = (bf16)f2bf(v[j]); } }
            WG_BAR();
        }
        }
#ifndef RS_H
#define RS_H 1
#endif
        for (int rh_ = 0; rh_ < RS_H; ++rh_)
        {   const int row = tid >> 2, q4 = tid & 3; const float* src = (const float*)(ws + WS_SHIN) + ((size_t)(bc * 4 + 2 * g + (row >> 6)) * 64 + (row & 63)) * 128 + q4 * 32;
#pragma unroll
            for (int q = 0; q < 4; ++q) { const f32x4 a = *(const f32x4*)(src + 8 * q), c = *(const f32x4*)(src + 8 * q + 4); u32x4 o; o.x = pk2(a.x, a.y); o.y = pk2(a.z, a.w); o.z = pk2(c.x, c.y); o.w = pk2(c.z, c.w);
                *(LAS u32x4*)(Hs + row * 136 + q4 * 32 + 8 * q) = o; } }
        WG_BAR();
        for (int rm_ = 0; rm_ < RS_MM; ++rm_)
        {   const int h = 2 * g + hh;
            bf16x8 cf[8];
#pragma unroll
            for (int ks = 0; ks < 8; ++ks) cf[ks] = *(const LAS bf16x8*)(Cs + lq * 136 + 16 * ks + 8 * hi);
            f32x16 ya[2] = {};
            const float acs_l = ACS[hh * 128 + lq];
            for (int st = 0; st <= (lb >> 1); ++st) {
                f32x16 G0 = {}, G1 = {};
#pragma unroll
                for (int ks = 0; ks < 8; ++ks) { const bf16x8 a0 = *(const LAS bf16x8*)(Bs + (64 * st + r32) * 136 + 16 * ks + 8 * hi), a1 = *(const LAS bf16x8*)(Bs + (64 * st + 32 + r32) * 136 + 16 * ks + 8 * hi);
                    G0 = MFMA32(a0, cf[ks], G0); G1 = MFMA32(a1, cf[ks], G1); }
#pragma unroll
                for (int r = 0; r < 16; ++r) { const int sa = 64 * st + crow(r, hi), sb = sa + 32;
                    const float wa = (sa <= lq) ? __expf(acs_l - ACS[hh * 128 + sa]) * DTV[hh * 128 + sa] : 0.f, wb = (sb <= lq) ? __expf(acs_l - ACS[hh * 128 + sb]) * DTV[hh * 128 + sb] : 0.f;
                    G0[r] *= wa; G1[r] *= wb; }
                bf16x8 pk[4];
#pragma unroll
                for (int sp = 0; sp < 4; ++sp) { u32x4 w;
                    if (sp < 2) { w.x = pk2(G0[8 * sp + 0], G0[8 * sp + 1]); w.y = pk2(G0[8 * sp + 2], G0[8 * sp + 3]); w.z = pk2(G0[8 * sp + 4], G0[8 * sp + 5]); w.w = pk2(G0[8 * sp + 6], G0[8 * sp + 7]); }
                    else { const int q = sp - 2; w.x = pk2(G1[8 * q + 0], G1[8 * q + 1]); w.y = pk2(G1[8 * q + 2], G1[8 * q + 3]); w.z = pk2(G1[8 * q + 4], G1[8 * q + 5]); w.w = pk2(G1[8 * q + 6], G1[8 * q + 7]); }
                    pk[sp] = __builtin_bit_cast(bf16x8, w); }
#pragma unroll
                for (int pb = 0; pb < 2; ++pb)
#pragma unroll
                    for (int sp = 0; sp < 4; ++sp) { const bf16x8 a = *(const LAS bf16x8*)(XT + (hh * 64 + 32 * pb + r32) * 136 + 64 * st + 16 * sp + 8 * hi); ya[pb] = MFMA32(a, pk[sp], ya[pb]); }
            }
            f32x16 yo[2] = {};
#pragma unroll
            for (int ks = 0; ks < 8; ++ks)
#pragma unroll
                for (int pb = 0; pb < 2; ++pb) { const bf16x8 a = *(const LAS bf16x8*)(Hs + (hh * 64 + 32 * pb + r32) * 136 + 16 * ks + 8 * hi); yo[pb] = MFMA32(a, cf[ks], yo[pb]); }
            const float e = __expf(acs_l), Dh = INF(I_SSD_D)[l * 4 + h]; float ss = 0.f; const int lp = perm16pos(lq);
            u32x2 zq[2][4];
#pragma unroll
            for (int pb = 0; pb < 2; ++pb)
#pragma unroll
                for (int r4 = 0; r4 < 4; ++r4) zq[pb][r4] = *(const u32x2*)(Ub + (size_t)(s0 + lq) * INC + U_SZ + h * 64 + 32 * pb + 8 * r4 + 4 * hi);
            __builtin_amdgcn_sched_barrier(0);
#pragma unroll
            for (int pb = 0; pb < 2; ++pb)
#pragma unroll
                for (int r4 = 0; r4 < 4; ++r4) { const int p0 = 32 * pb + 8 * r4 + 4 * hi;
                    const u32x2 zz = zq[pb][r4]; const float zv[4] = {lo_bf(zz.x), hi_bf(zz.x), lo_bf(zz.y), hi_bf(zz.y)};
#pragma unroll
                    for (int j = 0; j < 4; ++j) { const int r = 4 * r4 + j; const float xs = bf2f(XT[(hh * 64 + p0 + j) * 136 + lp]);
                        const float val = (ya[pb][r] + yo[pb][r] * e + Dh * xs) * siluf_(zv[j]); ya[pb][r] = val; ss += val * val; } }
            ss += __shfl_xor(ss, 32); if (hi == 0) SSQ[lq * 4 + h] = ss;
            yk[g][0] = ya[0]; yk[g][1] = ya[1];
        }
        WG_BAR();
    }
    const float rs = __builtin_amdgcn_rsqf((SSQ[lq * 4 + 0] + SSQ[lq * 4 + 1] + SSQ[lq * 4 + 2] + SSQ[lq * 4 + 3]) * (1.f / 256.f) + EPS);
    bf16* yrow = (bf16*)(ws + WS_Y) + (size_t)(b * SEQ + s0 + lq) * D + 768;
    f32x4 gnv[2][2][4];
#pragma unroll
    for (int g = 0; g < 2; ++g)
#pragma unroll
        for (int pb = 0; pb < 2; ++pb)
#pragma unroll
            for (int r4 = 0; r4 < 4; ++r4) gnv[g][pb][r4] = *(const f32x4*)(INF(I_GNORM) + (size_t)(l * 4 + 3) * 256 + (2 * g + hh) * 64 + 32 * pb + 8 * r4 + 4 * hi);
    __builtin_amdgcn_sched_barrier(0);
#pragma unroll
    for (int g = 0; g < 2; ++g)
#pragma unroll
        for (int pb = 0; pb < 2; ++pb)
#pragma unroll
            for (int r4 = 0; r4 < 4; ++r4) { const int c0 = (2 * g + hh) * 64 + 32 * pb + 8 * r4 + 4 * hi; const f32x4 gn = gnv[g][pb][r4];
                u32x2 w; w.x = pk2(yk[g][pb][4 * r4] * rs * gn.x, yk[g][pb][4 * r4 + 1] * rs * gn.y); w.y = pk2(yk[g][pb][4 * r4 + 2] * rs * gn.z, yk[g][pb][4 * r4 + 3] * rs * gn.w);
                *(u32x2*)(yrow + c0) = w; }
    WG_BAR();
}

__device__ __forceinline__ bf16x8 ldfrag(const LAS bf16* p) { return *(const LAS bf16x8*)p; }
__device__ __forceinline__ bf16x8 ldfrag(const bf16* p) { return *(const bf16x8*)p; }
struct NoMask { static constexpr bool ACTIVE = false; __device__ __forceinline__ bool operator()(int) const { return true; } };
template <int DK, int DV, class Mask, class PT>
__device__ __forceinline__ void flash_step(PT Kt, int ldk, PT Vt, int ldv, const bf16x8 (&qf)[DK / 16], f32x16 (&o)[DV / 32], float& mref, float& lsum, const Mask mk, int r32, int hi, bool colok = true) {
    const bool first = mref == -INFINITY; const float off = first ? 0.f : mref, noff = colok ? -off : -INFINITY;
    f32x16 s0, s1;
#pragma unroll
    for (int r = 0; r < 16; ++r) { s0[r] = noff; s1[r] = noff; }
#pragma unroll
    for (int d0 = 0; d0 < DK / 16; ++d0) {
        const bf16x8 k0 = ldfrag(Kt + r32 * ldk + 16 * d0 + 8 * hi), k1 = ldfrag(Kt + (32 + r32) * ldk + 16 * d0 + 8 * hi);
        s0 = MFMA32(k0, qf[d0], s0); s1 = MFMA32(k1, qf[d0], s1); }
    if (Mask::ACTIVE) {
#pragma unroll
        for (int r = 0; r < 16; ++r) { if (!mk(crow(r, hi))) s0[r] = -INFINITY; if (!mk(32 + crow(r, hi))) s1[r] = -INFINITY; } }
    float mx = fmaxf(s0[0], s1[0]);
#pragma unroll
    for (int r = 1; r < 16; ++r) mx = fmaxf(mx, fmaxf(s0[r], s1[r]));
    mx = fmaxf(mx, __shfl_xor(mx, 32));
    const bool need = first ? (mx > -INFINITY) : (mx > 8.0f);
    if (__any(need)) {
        const float d = need ? mx : 0.f, alpha = first ? 1.0f : __builtin_amdgcn_exp2f(-d);
        if (need) mref = off + d;
        lsum *= alpha;
#pragma unroll
        for (int db = 0; db < DV / 32; ++db) o[db] = o[db] * alpha;
#pragma unroll
        for (int r = 0; r < 16; ++r) { s0[r] -= d; s1[r] -= d; }
    }
    float ps = 0.f;
#pragma unroll
    for (int r = 0; r < 16; ++r) { s0[r] = __builtin_amdgcn_exp2f(s0[r]); s1[r] = __builtin_amdgcn_exp2f(s1[r]); ps += s0[r] + s1[r]; }
    lsum += ps;
    bf16x8 pk[4];
#pragma unroll
    for (int sp = 0; sp < 4; ++sp) { u32x4 w;
        if (sp < 2) { w.x = pk2(s0[8 * sp + 0], s0[8 * sp + 1]); w.y = pk2(s0[8 * sp + 2], s0[8 * sp + 3]); w.z = pk2(s0[8 * sp + 4], s0[8 * sp + 5]); w.w = pk2(s0[8 * sp + 6], s0[8 * sp + 7]); }
        else { const int q = sp - 2; w.x = pk2(s1[8 * q + 0], s1[8 * q + 1]); w.y = pk2(s1[8 * q + 2], s1[8 * q + 3]); w.z = pk2(s1[8 * q + 4], s1[8 * q + 5]); w.w = pk2(s1[8 * q + 6], s1[8 * q + 7]); }
        pk[sp] = __builtin_bit_cast(bf16x8, w); }
#pragma unroll
    for (int db = 0; db < DV / 32; ++db)
#pragma unroll
        for (int sp = 0; sp < 4; ++sp) { const bf16x8 a = ldfrag(Vt + (size_t)(32 * db + r32) * ldv + 16 * sp + 8 * hi); o[db] = MFMA32(a, pk[sp], o[db]); }
}

template <int DK, int DV, class Mask, class PT>
__device__ __forceinline__ void flash_step_fx(PT Kt, int ldk, PT Vt, int ldv, const bf16x8 (&qf)[DK / 16], f32x16 (&o)[DV / 32], float negref, float& lsum, const Mask mk, int r32, int hi, bool colok = true) {
    const float c0 = colok ? negref : -INFINITY;
    f32x16 s0, s1;
#ifndef REP_QK
#define REP_QK 1
#endif
    for (int rq_ = 0; rq_ < REP_QK; ++rq_) {
    f32x16 ci;
#pragma unroll
    for (int r = 0; r < 16; ++r) ci[r] = c0;
#pragma unroll
    for (int d0 = 0; d0 < DK / 16; ++d0) {
        const bf16x8 k0 = ldfrag(Kt + r32 * ldk + 16 * d0 + 8 * hi), k1 = ldfrag(Kt + (32 + r32) * ldk + 16 * d0 + 8 * hi);
        if (d0 == 0) { s0 = MFMA32(k0, qf[0], ci); s1 = MFMA32(k1, qf[0], ci); } else { s0 = MFMA32(k0, qf[d0], s0); s1 = MFMA32(k1, qf[d0], s1); } }
    if (REP_QK > 1) asm volatile("" : "+v"(s0), "+v"(s1)); }
    if (Mask::ACTIVE) {
#pragma unroll
        for (int r = 0; r < 16; ++r) { if (!mk(crow(r, hi))) s0[r] = -INFINITY; if (!mk(32 + crow(r, hi))) s1[r] = -INFINITY; } }
    float ps = 0.f;
#pragma unroll
    for (int r = 0; r < 16; ++r) { s0[r] = __builtin_amdgcn_exp2f(s0[r]); s1[r] = __builtin_amdgcn_exp2f(s1[r]); ps += s0[r] + s1[r]; }
    lsum += ps;
    bf16x8 pk[4];
#pragma unroll
    for (int sp = 0; sp < 4; ++sp) { u32x4 w;
        if (sp < 2) { w.x = pk2(s0[8 * sp + 0], s0[8 * sp + 1]); w.y = pk2(s0[8 * sp + 2], s0[8 * sp + 3]); w.z = pk2(s0[8 * sp + 4], s0[8 * sp + 5]); w.w = pk2(s0[8 * sp + 6], s0[8 * sp + 7]); }
        else { const int q = sp - 2; w.x = pk2(s1[8 * q + 0], s1[8 * q + 1]); w.y = pk2(s1[8 * q + 2], s1[8 * q + 3]); w.z = pk2(s1[8 * q + 4], s1[8 * q + 5]); w.w = pk2(s1[8 * q + 6], s1[8 * q + 7]); }
        pk[sp] = __builtin_bit_cast(bf16x8, w); }
#pragma unroll
    for (int sp = 0; sp < 4; ++sp)
#pragma unroll
        for (int db = 0; db < DV / 32; ++db) { const bf16x8 a = ldfrag(Vt + (size_t)(32 * db + r32) * ldv + 16 * sp + 8 * hi); o[db] = MFMA32(a, pk[sp], o[db]); }
}
template <int DK, class PT>
__device__ __forceinline__ void fx_qk(PT Kt, int ldk, const bf16x8 (&qf)[DK / 16], f32x16& s0, f32x16& s1, float c0, int r32, int hi) {
#pragma unroll
    for (int r = 0; r < 16; ++r) { s0[r] = c0; s1[r] = c0; }
#pragma unroll
    for (int d0 = 0; d0 < DK / 16; ++d0) {
        const bf16x8 k0 = ldfrag(Kt + r32 * ldk + 16 * d0 + 8 * hi), k1 = ldfrag(Kt + (32 + r32) * ldk + 16 * d0 + 8 * hi);
        s0 = MFMA32(k0, qf[d0], s0); s1 = MFMA32(k1, qf[d0], s1); }
}
template <int DV, class Mask, class PT>
__device__ __forceinline__ void fx_sv(f32x16& s0, f32x16& s1, PT Vt, int ldv, f32x16 (&o)[DV / 32], float& lsum, const Mask mk, int r32, int hi) {
    if (Mask::ACTIVE) {
#pragma unroll
        for (int r = 0; r < 16; ++r) { if (!mk(crow(r, hi))) s0[r] = -INFINITY; if (!mk(32 + crow(r, hi))) s1[r] = -INFINITY; } }
    float ps = 0.f;
#pragma unroll
    for (int r = 0; r < 16; ++r) { s0[r] = __builtin_amdgcn_exp2f(s0[r]); s1[r] = __builtin_amdgcn_exp2f(s1[r]); ps += s0[r] + s1[r]; }
    lsum += ps;
    bf16x8 pk[4];
#pragma unroll
    for (int sp = 0; sp < 4; ++sp) { u32x4 w;
        if (sp < 2) { w.x = pk2(s0[8 * sp + 0], s0[8 * sp + 1]); w.y = pk2(s0[8 * sp + 2], s0[8 * sp + 3]); w.z = pk2(s0[8 * sp + 4], s0[8 * sp + 5]); w.w = pk2(s0[8 * sp + 6], s0[8 * sp + 7]); }
        else { const int q = sp - 2; w.x = pk2(s1[8 * q + 0], s1[8 * q + 1]); w.y = pk2(s1[8 * q + 2], s1[8 * q + 3]); w.z = pk2(s1[8 * q + 4], s1[8 * q + 5]); w.w = pk2(s1[8 * q + 6], s1[8 * q + 7]); }
        pk[sp] = __builtin_bit_cast(bf16x8, w); }
#pragma unroll
    for (int sp = 0; sp < 4; ++sp)
#pragma unroll
        for (int db = 0; db < DV / 32; ++db) { const bf16x8 a = ldfrag(Vt + (size_t)(32 * db + r32) * ldv + 16 * sp + 8 * hi); o[db] = MFMA32(a, pk[sp], o[db]); }
}
template <int U>
__device__ __forceinline__ void fx_unit(f32x16& s0, f32x16& s1, unsigned (&P)[16], float& ps) {
    constexpr int b = 4 * (U & 3), nb = 4 * ((U + 1) & 3);
    const float e0 = __builtin_amdgcn_exp2f(U < 4 ? s0[b] : s1[b]), e1 = __builtin_amdgcn_exp2f(U < 4 ? s0[b + 1] : s1[b + 1]), e2 = __builtin_amdgcn_exp2f(U < 4 ? s0[b + 2] : s1[b + 2]), e3 = __builtin_amdgcn_exp2f(U < 4 ? s0[b + 3] : s1[b + 3]);
    ps += (e0 + e1) + (e2 + e3); P[2 * U] = pk2(e0, e1); P[2 * U + 1] = pk2(e2, e3);
    if (U < 7) { float n0 = U + 1 < 4 ? s0[nb] : s1[nb], n1 = U + 1 < 4 ? s0[nb + 1] : s1[nb + 1], n2 = U + 1 < 4 ? s0[nb + 2] : s1[nb + 2], n3 = U + 1 < 4 ? s0[nb + 3] : s1[nb + 3];
        asm volatile("" : "+v"(P[2 * U]), "+v"(P[2 * U + 1]), "+v"(ps), "+v"(n0), "+v"(n1), "+v"(n2), "+v"(n3));
        if (U + 1 < 4) { s0[nb] = n0; s0[nb + 1] = n1; s0[nb + 2] = n2; s0[nb + 3] = n3; } else { s1[nb] = n0; s1[nb + 1] = n1; s1[nb + 2] = n2; s1[nb + 3] = n3; } }
    else asm volatile("" : "+v"(P[2 * U]), "+v"(P[2 * U + 1]), "+v"(ps));
}
template <int NF> __device__ __forceinline__ float qnorm2(const bf16x8 (&qf)[NF]) {
    float s = 0.f;
#pragma unroll
    for (int f = 0; f < NF; ++f) { const u32x4 w = __builtin_bit_cast(u32x4, qf[f]); const unsigned ww[4] = {w.x, w.y, w.z, w.w};
#pragma unroll
        for (int j = 0; j < 4; ++j) { const float a = lo_bf(ww[j]), b = hi_bf(ww[j]); s += a * a + b * b; } }
    return s + __shfl_xor(s, 32);
}

template <int DK, class PT>
__device__ __forceinline__ void flash_qk(PT Kt, int ldk, const bf16x8 (&qf)[DK / 16], f32x16& s0, f32x16& s1, int r32, int hi) {
    s0 = f32x16{}; s1 = f32x16{};
#pragma unroll
    for (int d0 = 0; d0 < DK / 16; ++d0) {
        const bf16x8 k0 = ldfrag(Kt + r32 * ldk + 16 * d0 + 8 * hi), k1 = ldfrag(Kt + (32 + r32) * ldk + 16 * d0 + 8 * hi);
        s0 = MFMA32(k0, qf[d0], s0); s1 = MFMA32(k1, qf[d0], s1);
}
}
template <int DV, class Mask>
__device__ __forceinline__ void flash_softmax(f32x16& s0, f32x16& s1, bf16x8 (&pk)[4], f32x16 (&o)[DV / 32], float& mref, float& lsum, const Mask mk, int hi, bool colok = true) {
    if (Mask::ACTIVE) {
#pragma unroll
        for (int r = 0; r < 16; ++r) { if (!mk(crow(r, hi))) s0[r] = -INFINITY; if (!mk(32 + crow(r, hi))) s1[r] = -INFINITY; } }
    float mx = fmaxf(s0[0], s1[0]);
#pragma unroll
    for (int r = 1; r < 16; ++r) mx = fmaxf(mx, fmaxf(s0[r], s1[r]));
    mx = fmaxf(mx, __shfl_xor(mx, 32));
    if (!colok) mx = -INFINITY;
    const bool first = mref == -INFINITY;
    const bool need = first ? (mx > -INFINITY) : (mx - mref > 8.0f);
    if (__any(need)) {
        const float alpha = (need && !first) ? __builtin_amdgcn_exp2f(mref - mx) : 1.0f;
        if (need) mref = mx;
        lsum *= alpha;
#pragma unroll
        for (int db = 0; db < DV / 32; ++db) o[db] = o[db] * alpha;
    }
    const float sub = colok ? (mref == -INFINITY ? 0.f : mref) : INFINITY;
    float ps = 0.f;
#pragma unroll
    for (int r = 0; r < 16; ++r) { s0[r] = __builtin_amdgcn_exp2f(s0[r] - sub); s1[r] = __builtin_amdgcn_exp2f(s1[r] - sub); ps += s0[r] + s1[r]; }
    lsum += ps;
#pragma unroll
    for (int sp = 0; sp < 4; ++sp) { u32x4 w;
        if (sp < 2) { w.x = pk2(s0[8 * sp + 0], s0[8 * sp + 1]); w.y = pk2(s0[8 * sp + 2], s0[8 * sp + 3]); w.z = pk2(s0[8 * sp + 4], s0[8 * sp + 5]); w.w = pk2(s0[8 * sp + 6], s0[8 * sp + 7]); }
        else { const int q = sp - 2; w.x = pk2(s1[8 * q + 0], s1[8 * q + 1]); w.y = pk2(s1[8 * q + 2], s1[8 * q + 3]); w.z = pk2(s1[8 * q + 4], s1[8 * q + 5]); w.w = pk2(s1[8 * q + 6], s1[8 * q + 7]); }
        pk[sp] = __builtin_bit_cast(bf16x8, w); }
}
template <int DV, class PT>
__device__ __forceinline__ void flash_pv(const bf16x8 (&pk)[4], PT Vt, int ldv, f32x16 (&o)[DV / 32], int r32, int hi) {
#pragma unroll
    for (int db = 0; db < DV / 32; ++db)
#pragma unroll
        for (int sp = 0; sp < 4; ++sp) { const bf16x8 a = ldfrag(Vt + (size_t)(32 * db + r32) * ldv + 16 * sp + 8 * hi); o[db] = MFMA32(a, pk[sp], o[db]); }
}
template <int DV, class Mask, class PT>
__device__ __forceinline__ void flash_sv(f32x16& s0, f32x16& s1, PT Vt, int ldv, f32x16 (&o)[DV / 32], float& mref, float& lsum, const Mask mk, int r32, int hi, bool colok = true) {
    bf16x8 pk[4]; flash_softmax<DV, Mask>(s0, s1, pk, o, mref, lsum, mk, hi, colok); flash_pv<DV, PT>(pk, Vt, ldv, o, r32, hi);
}

template <class Mask>
__device__ __forceinline__ void flash_step_frag(const bf16x8 (&kf)[2][4], const bf16x8 (&vf)[2][4], const bf16x8 (&qf)[4], f32x16 (&o)[2], float& mref, float& lsum, const Mask mk, int hi) {
    const bool first = mref == -INFINITY; const float off = first ? 0.f : mref, noff = -off;
    f32x16 s0, s1;
#pragma unroll
    for (int r = 0; r < 16; ++r) { s0[r] = noff; s1[r] = noff; }
#pragma unroll
    for (int d0 = 0; d0 < 4; ++d0) { s0 = MFMA32(kf[0][d0], qf[d0], s0); s1 = MFMA32(kf[1][d0], qf[d0], s1); }
    if (Mask::ACTIVE) {
#pragma unroll
        for (int r = 0; r < 16; ++r) { if (!mk(crow(r, hi))) s0[r] = -INFINITY; if (!mk(32 + crow(r, hi))) s1[r] = -INFINITY; } }
    float mx = fmaxf(s0[0], s1[0]);
#pragma unroll
    for (int r = 1; r < 16; ++r) mx = fmaxf(mx, fmaxf(s0[r], s1[r]));
    mx = fmaxf(mx, __shfl_xor(mx, 32));
    const bool need = first ? (mx > -INFINITY) : (mx > 8.0f);
    if (__any(need)) {
        const float d = need ? mx : 0.f, alpha = first ? 1.0f : __builtin_amdgcn_exp2f(-d);
        if (need) mref = off + d;
        lsum *= alpha; o[0] = o[0] * alpha; o[1] = o[1] * alpha;
#pragma unroll
        for (int r = 0; r < 16; ++r) { s0[r] -= d; s1[r] -= d; }
    }
    float ps = 0.f;
#pragma unroll
    for (int r = 0; r < 16; ++r) { s0[r] = __builtin_amdgcn_exp2f(s0[r]); s1[r] = __builtin_amdgcn_exp2f(s1[r]); ps += s0[r] + s1[r]; }
    lsum += ps;
    bf16x8 pk[4];
#pragma unroll
    for (int sp = 0; sp < 4; ++sp) { u32x4 w;
        if (sp < 2) { w.x = pk2(s0[8 * sp + 0], s0[8 * sp + 1]); w.y = pk2(s0[8 * sp + 2], s0[8 * sp + 3]); w.z = pk2(s0[8 * sp + 4], s0[8 * sp + 5]); w.w = pk2(s0[8 * sp + 6], s0[8 * sp + 7]); }
        else { const int q = sp - 2; w.x = pk2(s1[8 * q + 0], s1[8 * q + 1]); w.y = pk2(s1[8 * q + 2], s1[8 * q + 3]); w.z = pk2(s1[8 * q + 4], s1[8 * q + 5]); w.w = pk2(s1[8 * q + 6], s1[8 * q + 7]); }
        pk[sp] = __builtin_bit_cast(bf16x8, w); }
#pragma unroll
    for (int db = 0; db < 2; ++db)
#pragma unroll
        for (int sp = 0; sp < 4; ++sp) o[db] = MFMA32(vf[db][sp], pk[sp], o[db]);
}

constexpr float MLA_QS = 0.10206207261596575f * 1.4426950408889634f;
__device__ __forceinline__ void mla_prep_tile(const Args& A, int l, int tile, LAS unsigned char* lds) {
    unsigned char* ws = A.ws;
    int tid = threadIdx.x; asm volatile("" : "+v"(tid)); const int lane = tid & 63, wid = __builtin_amdgcn_readfirstlane(tid >> 6), r32 = lane & 31, hi = lane >> 5;
    const int tok0 = tile * 64, b = tok0 / SEQ, s0 = tok0 % SEQ;
    LAS bf16* Aq = (LAS bf16*)lds; LAS bf16* Akv = (LAS bf16*)(lds + 25600);
    const bf16* U = (const bf16*)(ws + WS_U);
    bf16* Qo = (bf16*)(ws + WS_MQ); bf16* Ko = (bf16*)(ws + WS_MK); bf16* VTo = (bf16*)(ws + WS_MVT);
    const float* cosm = (const float*)(ws + WS_ROPEM); const float* sinm = cosm + SEQ * 16;
    bf16x8 wfr[2][12];
    const bf16* Wq_ = (const bf16*)(ws + WS_WUQ) + (size_t)l * 384 * 192 + (size_t)r32 * 192 + 8 * hi; const bf16* Wkv_ = (const bf16*)(ws + WS_WUKV) + (size_t)l * 512 * 128 + (size_t)r32 * 128 + 8 * hi;
#define MLAP_LDW(slot, i) do { if ((i) < 3) { const bf16* wp_ = Wq_ + (size_t)(32 * ((wid >> 1) + 4 * (i))) * 192; _Pragma("unroll") for (int ks = 0; ks < 12; ++ks) wfr[slot][ks] = *(const bf16x8*)(wp_ + 16 * ks); } \
        else { const bf16* wp_ = Wkv_ + (size_t)(32 * (4 * ((i) - 3) + (wid >> 1))) * 128; _Pragma("unroll") for (int ks = 0; ks < 8; ++ks) wfr[slot][ks] = *(const bf16x8*)(wp_ + 16 * ks); } } while (0)
    MLAP_LDW(0, 0);
#ifndef REP_PA
#define REP_PA 1
#endif
#ifndef REP_PB
#define REP_PB 1
#endif
    for (int rpa_ = 0; rpa_ < REP_PA; ++rpa_)
    {   const int tt = tid >> 3, sub = tid & 7; const bf16* ur = U + (size_t)(tok0 + tt) * INC; const int s = s0 + tt;
        u32x4 wq[3], wk[2]; f32x4 gqv[6], gkv[4];
#pragma unroll
        for (int q = 0; q < 3; ++q) wq[q] = *(const u32x4*)(ur + U_CQ + sub * 24 + 8 * q);
#pragma unroll
        for (int q = 0; q < 2; ++q) wk[q] = *(const u32x4*)(ur + U_CKV + sub * 16 + 8 * q);
        const unsigned w1 = *(const unsigned*)(ur + U_KPE + 2 * sub), w2 = *(const unsigned*)(ur + U_KPE + 16 + 2 * sub);
#pragma unroll
        for (int q = 0; q < 6; ++q) gqv[q] = *(const f32x4*)(INF(I_MLA_QN) + l * 192 + sub * 24 + 4 * q);
#pragma unroll
        for (int q = 0; q < 4; ++q) gkv[q] = *(const f32x4*)(INF(I_MLA_KVN) + l * 128 + sub * 16 + 4 * q);
        const f32x2_t cc = *(const f32x2_t*)(cosm + s * 16 + 2 * sub), nn = *(const f32x2_t*)(sinm + s * 16 + 2 * sub);
        float v[24]; float ss = 0.f;
#pragma unroll
        for (int q = 0; q < 3; ++q) { const unsigned ww[4] = {wq[q].x, wq[q].y, wq[q].z, wq[q].w};
#pragma unroll
            for (int j = 0; j < 4; ++j) { v[8 * q + 2 * j] = lo_bf(ww[j]); v[8 * q + 2 * j + 1] = hi_bf(ww[j]); } }
#pragma unroll
        for (int j = 0; j < 24; ++j) ss += v[j] * v[j];
        ss += __shfl_xor(ss, 1); ss += __shfl_xor(ss, 2); ss += __shfl_xor(ss, 4);
        float rs = __builtin_amdgcn_rsqf(ss * (1.f / 192.f) + EPS);
#pragma unroll
        for (int q = 0; q < 3; ++q) { const f32x4 g0 = gqv[2 * q], g1 = gqv[2 * q + 1]; u32x4 o; o.x = pk2(v[8 * q] * rs * g0.x, v[8 * q + 1] * rs * g0.y); o.y = pk2(v[8 * q + 2] * rs * g0.z, v[8 * q + 3] * rs * g0.w);
            o.z = pk2(v[8 * q + 4] * rs * g1.x, v[8 * q + 5] * rs * g1.y); o.w = pk2(v[8 * q + 6] * rs * g1.z, v[8 * q + 7] * rs * g1.w);
            *(LAS u32x4*)(Aq + tt * 200 + sub * 24 + 8 * q) = o; }
        ss = 0.f;
#pragma unroll
        for (int q = 0; q < 2; ++q) { const unsigned ww[4] = {wk[q].x, wk[q].y, wk[q].z, wk[q].w};
#pragma unroll
            for (int j = 0; j < 4; ++j) { v[8 * q + 2 * j] = lo_bf(ww[j]); v[8 * q + 2 * j + 1] = hi_bf(ww[j]); } }
#pragma unroll
        for (int j = 0; j < 16; ++j) ss += v[j] * v[j];
        ss += __shfl_xor(ss, 1); ss += __shfl_xor(ss, 2); ss += __shfl_xor(ss, 4);
        rs = __builtin_amdgcn_rsqf(ss * (1.f / 128.f) + EPS);
#pragma unroll
        for (int q = 0; q < 2; ++q) { const f32x4 g0 = gkv[2 * q], g1 = gkv[2 * q + 1]; u32x4 o; o.x = pk2(v[8 * q] * rs * g0.x, v[8 * q + 1] * rs * g0.y); o.y = pk2(v[8 * q + 2] * rs * g0.z, v[8 * q + 3] * rs * g0.w);
            o.z = pk2(v[8 * q + 4] * rs * g1.x, v[8 * q + 5] * rs * g1.y); o.w = pk2(v[8 * q + 6] * rs * g1.z, v[8 * q + 7] * rs * g1.w);
            *(LAS u32x4*)(Akv + tt * 136 + sub * 16 + 8 * q) = o; }
        const float c0 = cc.x, c1 = cc.y, n0 = nn.x, n1 = nn.y;
        const float a0 = lo_bf(w1), a1 = hi_bf(w1), b0 = lo_bf(w2), b1 = hi_bf(w2);
        const unsigned o1 = pk2(a0 * c0 - b0 * n0, a1 * c1 - b1 * n1), o2 = pk2(b0 * c0 + a0 * n0, b1 * c1 + a1 * n1);
        bf16* kr = Ko + (size_t)(tok0 + tt) * 384;
#pragma unroll
        for (int h = 0; h < 4; ++h) { *(unsigned*)(kr + h * 96 + 64 + 2 * sub) = o1; *(unsigned*)(kr + h * 96 + 80 + 2 * sub) = o2; }
        {   float kss = (a0 * a0 + a1 * a1) + (b0 * b0 + b1 * b1);
            kss += __shfl_xor(kss, 1); kss += __shfl_xor(kss, 2); kss += __shfl_xor(kss, 4);
            kss = fmaxf(kss, __shfl_xor(kss, 8)); kss = fmaxf(kss, __shfl_xor(kss, 16)); kss = fmaxf(kss, __shfl_xor(kss, 32));
            if (lane == 0) kmax_update((LAS unsigned*)(lds + LDS_MISC + 64), 64 + b, kss); }
    }
    const int tb = wid & 1, tok = tok0 + 32 * tb + r32, s = s0 + 32 * tb + r32;
    f32x4 rcq[2], rsq[2];
#pragma unroll
    for (int r4 = 0; r4 < 2; ++r4) { rcq[r4] = *(const f32x4*)(cosm + s * 16 + 8 * r4 + 4 * hi); rsq[r4] = *(const f32x4*)(sinm + s * 16 + 8 * r4 + 4 * hi); }
    WG_BAR();
    {
        const int part = wid >> 1;
        for (int rpb_ = 0; rpb_ < REP_PB; ++rpb_) { if (rpb_) MLAP_LDW(0, 0);
#pragma unroll
        for (int i = 0; i < 7; ++i) {
            if (i + 1 < 7) MLAP_LDW((i + 1) & 1, i + 1);
            if (i < 3) { const int fb = (wid >> 1) + 4 * i, head = fb / 3, qpart = fb % 3; f32x16 acc = {};
#pragma unroll
                for (int ks = 0; ks < 12; ++ks) { const bf16x8 bq = *(const LAS bf16x8*)(Aq + (32 * tb + r32) * 200 + 16 * ks + 8 * hi); acc = MFMA32(wfr[i & 1][ks], bq, acc); }
                bf16* qr = Qo + (size_t)tok * 384 + head * 96;
                if (qpart < 2) {
#pragma unroll
                    for (int r4 = 0; r4 < 4; ++r4) { u32x2 w; w.x = pk2(acc[4 * r4] * MLA_QS, acc[4 * r4 + 1] * MLA_QS); w.y = pk2(acc[4 * r4 + 2] * MLA_QS, acc[4 * r4 + 3] * MLA_QS); *(u32x2*)(qr + 32 * qpart + 8 * r4 + 4 * hi) = w; }
                } else {
#pragma unroll
                    for (int r4 = 0; r4 < 2; ++r4) { float o1[4], o2[4];
#pragma unroll
                        for (int j = 0; j < 4; ++j) { const float c = rcq[r4][j], sn = rsq[r4][j], x1 = acc[4 * r4 + j], x2 = acc[4 * r4 + j + 8];
                            o1[j] = (x1 * c - x2 * sn) * MLA_QS; o2[j] = (x2 * c + x1 * sn) * MLA_QS; }
                        u32x2 w; w.x = pk2(o1[0], o1[1]); w.y = pk2(o1[2], o1[3]); *(u32x2*)(qr + 64 + 8 * r4 + 4 * hi) = w;
                        w.x = pk2(o2[0], o2[1]); w.y = pk2(o2[2], o2[3]); *(u32x2*)(qr + 80 + 8 * r4 + 4 * hi) = w; }
                }
            } else { const int head = i - 3; f32x16 acc = {};
#pragma unroll
                for (int ks = 0; ks < 8; ++ks) { const bf16x8 bq = *(const LAS bf16x8*)(Akv + (32 * tb + r32) * 136 + 16 * ks + 8 * hi); acc = MFMA32(wfr[i & 1][ks], bq, acc); }
                if (part < 2) { bf16* kr = Ko + (size_t)tok * 384 + head * 96 + 32 * part;
#pragma unroll
                    for (int r4 = 0; r4 < 4; ++r4) { u32x2 w; w.x = pk2(acc[4 * r4], acc[4 * r4 + 1]); w.y = pk2(acc[4 * r4 + 2], acc[4 * r4 + 3]); *(u32x2*)(kr + 8 * r4 + 4 * hi) = w; }
                    float kss = 0.f;
#pragma unroll
                    for (int r = 0; r < 16; ++r) kss += acc[r] * acc[r];
                    kss += __shfl_xor(kss, 32);
#pragma unroll
                    for (int o_ = 1; o_ < 32; o_ <<= 1) kss = fmaxf(kss, __shfl_xor(kss, o_));
                    if (lane == 0) kmax_update((LAS unsigned*)(lds + LDS_MISC + 64), (b * 4 + head) * 4 + part, kss);
                } else { bf16* vt = VTo + ((size_t)(b * 4 + head) * 64 + 32 * (part - 2)) * SEQ + perm16pos(s);
#ifndef REP_VS
#define REP_VS 1
#endif
                    for (int rv_ = 0; rv_ < REP_VS; ++rv_) {
#pragma unroll
                    for (int r = 0; r < 16; ++r) vt[(size_t)crow(r, hi) * SEQ] = (bf16)f2bf(acc[r]); } }
            }
        } }
    }
#undef MLAP_LDW
    WG_BAR();
}
struct CausalMask { static constexpr bool ACTIVE = true; int lim;
    __device__ __forceinline__ bool operator()(int k) const { return k <= lim; } };
__device__ __forceinline__ void mla_attn_unit(const Args& A, int l, int bh, int qb, LAS unsigned char* lds) {
    unsigned char* ws = A.ws;
    int tid = threadIdx.x; asm volatile("" : "+v"(tid)); const int lane = tid & 63, wid = __builtin_amdgcn_readfirstlane(tid >> 6), r32 = lane & 31, hi = lane >> 5;
    const int b = bh >> 2, h = bh & 3, q0 = qb * 256, nt = (q0 + 256) / 64;
    if (wid >= 4) __builtin_amdgcn_s_setprio(1);
    const bf16* Qg = (const bf16*)(ws + WS_MQ) + (size_t)(b * SEQ) * 384 + h * 96; const bf16* Kg = (const bf16*)(ws + WS_MK) + (size_t)(b * SEQ) * 384 + h * 96;
    const bf16* VTg = (const bf16*)(ws + WS_MVT) + (size_t)(b * 4 + h) * 64 * SEQ;
    constexpr int LDK = 104, LDV = 72, KB = 64 * LDK * 2, VB = 64 * LDV * 2;
    const int qrow = q0 + 32 * wid + r32;
    bf16x8 qf[6];
#pragma unroll
    for (int d0 = 0; d0 < 6; ++d0) qf[d0] = *(const bf16x8*)(Qg + (size_t)qrow * 384 + 16 * d0 + 8 * hi);
    f32x16 o[2] = {}; float ls = 0.f;
    const int c1 = tid < 256 ? tid + 512 : tid;
    const int kk0 = tid / 12, kc0 = tid % 12, kk1 = c1 / 12, kc1 = c1 % 12, vd = tid >> 3, vc = tid & 7;
    u32x4 ra0, ra1, rav;
#define MLA_LOAD1(R0, R1, RV, kt) do { const int kt_ = (kt) < nt ? (kt) : nt - 1; R0 = *(const u32x4*)(Kg + (size_t)(kt_ * 64 + kk0) * 384 + 8 * kc0); R1 = *(const u32x4*)(Kg + (size_t)(kt_ * 64 + kk1) * 384 + 8 * kc1); \
        RV = *(const u32x4*)(VTg + (size_t)vd * SEQ + kt_ * 64 + 8 * vc); } while (0)
#define MLA_STORE1(R0, R1, RV, buf) do { LAS unsigned char* kb_ = lds + (buf) * (KB + VB); *(LAS u32x4*)(kb_ + (kk0 * LDK + 8 * kc0) * 2) = R0; *(LAS u32x4*)(kb_ + (kk1 * LDK + 8 * kc1) * 2) = R1; \
        *(LAS u32x4*)(kb_ + KB + (vd * LDV + 8 * vc) * 2) = RV; } while (0)
#define MLA_STEP(kt, buf) do { if ((kt) <= ktmax) { const LAS bf16* Kt = (const LAS bf16*)(lds + (buf) * (KB + VB)); const LAS bf16* Vt = (const LAS bf16*)(lds + (buf) * (KB + VB) + KB); \
            if ((kt) * 64 + 63 > q0 + 32 * wid) { int hi_ = hi; asm volatile("" : "+v"(hi_));     \
                flash_step_fx<96, 64, CausalMask, const LAS bf16*>(Kt, LDK, Vt, LDV, qf, o, negref, ls, CausalMask{qrow - (kt) * 64}, r32, hi_); } \
            else flash_step_fx<96, 64, NoMask, const LAS bf16*>(Kt, LDK, Vt, LDV, qf, o, negref, ls, NoMask{}, r32, hi); } } while (0)
    const int ktmax = (q0 + 32 * wid + 31) / 64;
    MLA_LOAD1(ra0, ra1, rav, 0);
    float negref; { const float k2 = kmax_read(ws, l, (b * 4 + h) * 4, lane, (int)gridDim.x) + kmax_read(ws, l, (b * 4 + h) * 4 + 1, lane, (int)gridDim.x) + kmax_read(ws, l, 64 + b, lane, (int)gridDim.x);
        negref = -(sqrtf(qnorm2<6>(qf) * k2) * 1.02f + 0.25f); }
    MLA_STORE1(ra0, ra1, rav, 0); MLA_LOAD1(ra0, ra1, rav, 1); MLA_STORE1(ra0, ra1, rav, 1);
    WG_BAR();
    for (int kt = 0, pb = 0; kt < nt; kt += 2, pb ^= 2) {
        MLA_LOAD1(ra0, ra1, rav, kt + 2);
        if (kt + 1 < ktmax) {
            const LAS bf16* kfa = (const LAS bf16*)(lds + pb * (KB + VB)) + r32 * LDK + 8 * hi; const LAS bf16* kfb = kfa + (KB + VB) / 2;
            const LAS bf16* vfa = (const LAS bf16*)(lds + pb * (KB + VB) + KB) + r32 * LDV + 8 * hi; const LAS bf16* vfb = vfa + (KB + VB) / 2;
            f32x16 sa0, sa1, sb0, sb1, cneg; unsigned pa[16], pq[16]; float ps = 0.f;
            { float nr = negref; asm volatile("" : "+v"(nr));
#pragma unroll
              for (int r = 0; r < 16; ++r) cneg[r] = nr; }
            bf16x8 f0 = ldfrag(kfa), f1 = ldfrag(kfa + 32 * LDK), n0, n1;
#define SB() __builtin_amdgcn_sched_barrier(0)
#define FX_PK(P, sp) __builtin_bit_cast(bf16x8, (u32x4){P[4 * (sp)], P[4 * (sp) + 1], P[4 * (sp) + 2], P[4 * (sp) + 3]})
#pragma unroll
            for (int d0 = 0; d0 < 6; ++d0) {
                if (d0 < 5) { n0 = ldfrag(kfa + 16 * (d0 + 1)); n1 = ldfrag(kfa + 32 * LDK + 16 * (d0 + 1)); } else { n0 = ldfrag(kfb); n1 = ldfrag(kfb + 32 * LDK); }
                if (d0 == 0) { sa0 = MFMA32(f0, qf[0], cneg); sa1 = MFMA32(f1, qf[0], cneg); } else { sa0 = MFMA32(f0, qf[d0], sa0); sa1 = MFMA32(f1, qf[d0], sa1); }
                f0 = n0; f1 = n1; SB(); }
#pragma unroll
            for (int d0 = 0; d0 < 6; ++d0) {
                if (d0 < 5) { n0 = ldfrag(kfb + 16 * (d0 + 1)); n1 = ldfrag(kfb + 32 * LDK + 16 * (d0 + 1)); } else { n0 = ldfrag(vfa); n1 = ldfrag(vfa + 32 * LDV); }
                if (d0 == 0) sb0 = MFMA32(f0, qf[0], cneg); else sb0 = MFMA32(f0, qf[d0], sb0);
                if (d0 == 0) fx_unit<0>(sa0, sa1, pa, ps); else if (d0 == 1) fx_unit<2>(sa0, sa1, pa, ps); else if (d0 == 2) fx_unit<3>(sa0, sa1, pa, ps); else if (d0 == 3) fx_unit<4>(sa0, sa1, pa, ps); else if (d0 == 4) fx_unit<6>(sa0, sa1, pa, ps); else fx_unit<7>(sa0, sa1, pa, ps);
                SB();
                if (d0 == 0) sb1 = MFMA32(f1, qf[0], cneg); else sb1 = MFMA32(f1, qf[d0], sb1);
                if (d0 == 0) fx_unit<1>(sa0, sa1, pa, ps); else if (d0 == 3) fx_unit<5>(sa0, sa1, pa, ps);
                f0 = n0; f1 = n1; SB(); }
#pragma unroll
            for (int ix = 0; ix < 8; ++ix) {
                if (ix < 6) n0 = ldfrag(vfa + 32 * ((ix + 2) & 1) * LDV + 16 * ((ix + 2) >> 1)); else n0 = ldfrag(vfb + 32 * (ix & 1) * LDV);
                o[ix & 1] = MFMA32(f0, FX_PK(pa, ix >> 1), o[ix & 1]);
                if (ix == 0) fx_unit<0>(sb0, sb1, pq, ps); else if (ix == 1) fx_unit<1>(sb0, sb1, pq, ps); else if (ix == 2) fx_unit<2>(sb0, sb1, pq, ps); else if (ix == 3) fx_unit<3>(sb0, sb1, pq, ps); else if (ix == 4) fx_unit<4>(sb0, sb1, pq, ps); else if (ix == 5) fx_unit<5>(sb0, sb1, pq, ps); else if (ix == 6) fx_unit<6>(sb0, sb1, pq, ps); else fx_unit<7>(sb0, sb1, pq, ps);
                if (ix == 3) { MLA_STORE1(ra0, ra1, rav, pb ^ 2); MLA_LOAD1(ra0, ra1, rav, kt + 3); }
                f0 = f1; f1 = n0; SB(); }
#pragma unroll
            for (int ix = 0; ix < 8; ++ix) {
                if (ix < 6) n0 = ldfrag(vfb + 32 * ((ix + 2) & 1) * LDV + 16 * ((ix + 2) >> 1));
                o[ix & 1] = MFMA32(f0, FX_PK(pq, ix >> 1), o[ix & 1]);
                f0 = f1; f1 = n0; SB(); }
            ls += ps;
#undef FX_PK
#undef SB
        } else { MLA_STEP(kt, pb); MLA_STORE1(ra0, ra1, rav, pb ^ 2); MLA_LOAD1(ra0, ra1, rav, kt + 3); MLA_STEP(kt + 1, pb + 1); }
        MLA_STORE1(ra0, ra1, rav, (pb ^ 2) + 1);
        WG_BAR();
    }
#undef MLA_LOAD1
#undef MLA_STORE1
#undef MLA_STEP
    __builtin_amdgcn_s_setprio(0);
    ls += __shfl_xor(ls, 32); const float inv = 1.0f / ls;
    bf16* yr = (bf16*)(ws + WS_MRAW) + (size_t)(b * SEQ + qrow) * 256 + h * 64;
#pragma unroll
    for (int db = 0; db < 2; ++db)
#pragma unroll
        for (int r4 = 0; r4 < 4; ++r4) { u32x2 w; w.x = pk2(o[db][4 * r4] * inv, o[db][4 * r4 + 1] * inv); w.y = pk2(o[db][4 * r4 + 2] * inv, o[db][4 * r4 + 3] * inv); *(u32x2*)(yr + 32 * db + 8 * r4 + 4 * hi) = w; }
}
__device__ __forceinline__ void group_norm_tile(const Args& A, int l, int tile, int grp) {
    unsigned char* ws = A.ws; int tid = threadIdx.x; asm volatile("" : "+v"(tid)); const int tt = tid >> 3, sub = tid & 7; const int tok = tile * 64 + tt;
    const u32x4* rp = (const u32x4*)((const bf16*)(ws + WS_MRAW) + (size_t)tok * 256 + sub * 32);
    u32x4* yp = (u32x4*)((bf16*)(ws + WS_Y) + (size_t)tok * D + grp * 256 + sub * 32); const f32x4* gn = (const f32x4*)(INF(I_GNORM) + (size_t)(l * 4 + grp) * 256 + sub * 32);
    float v[32]; float ss = 0.f;
    f32x4 gnv[8];
#pragma unroll
    for (int q = 0; q < 8; ++q) gnv[q] = gn[q];
#pragma unroll
    for (int q = 0; q < 4; ++q) { const u32x4 w = rp[q]; const unsigned ww[4] = {w.x, w.y, w.z, w.w};
#pragma unroll
        for (int j = 0; j < 4; ++j) { v[8 * q + 2 * j] = lo_bf(ww[j]); v[8 * q + 2 * j + 1] = hi_bf(ww[j]); ss += v[8 * q + 2 * j] * v[8 * q + 2 * j] + v[8 * q + 2 * j + 1] * v[8 * q + 2 * j + 1]; } }
    ss += __shfl_xor(ss, 1); ss += __shfl_xor(ss, 2); ss += __shfl_xor(ss, 4);
    const float rs = __builtin_amdgcn_rsqf(ss * (1.f / 256.f) + EPS);
#pragma unroll
    for (int q = 0; q < 4; ++q) { const f32x4 g0 = gnv[2 * q], g1 = gnv[2 * q + 1]; u32x4 w;
        w.x = pk2(v[8 * q] * rs * g0.x, v[8 * q + 1] * rs * g0.y); w.y = pk2(v[8 * q + 2] * rs * g0.z, v[8 * q + 3] * rs * g0.w);
        w.z = pk2(v[8 * q + 4] * rs * g1.x, v[8 * q + 5] * rs * g1.y); w.w = pk2(v[8 * q + 6] * rs * g1.z, v[8 * q + 7] * rs * g1.w); yp[q] = w; }
}

constexpr float NSA_QS = 0.125f * 1.4426950408889634f;
__device__ __forceinline__ void nsa_prep_tile(const Args& A, int l, int tile, LAS unsigned char* lds) {
    unsigned char* ws = A.ws;
    int tid = threadIdx.x; asm volatile("" : "+v"(tid)); const int lane = tid & 63, wid = __builtin_amdgcn_readfirstlane(tid >> 6);
    const int tok0 = tile * 64, b = tok0 / SEQ, s0 = tok0 % SEQ;
    LAS bf16* Kc = (LAS bf16*)lds; LAS bf16* Vc = (LAS bf16*)(lds + 11520);
    const float* cosn = (const float*)(ws + WS_ROPEN); const float* sinn = cosn + SEQ * 8;
    bf16x8 cwf[2][8];
    const bf16* Wc_ = (const bf16*)(ws + WS_WCT) + (size_t)(l * 2 + (wid & 1)) * 64 * 2048 + (size_t)(16 * (wid >> 1) + (lane & 15)) * 2048 + 8 * (lane >> 4);
#pragma unroll
    for (int j = 0; j < 8; ++j) cwf[0][j] = *(const bf16x8*)(Wc_ + 32 * j);
    {   const int tt = tid >> 3, sub = tid & 7, tok = tok0 + tt, s = s0 + tt; const bf16* ur = (const bf16*)(ws + WS_U) + (size_t)tok * INC;
        const int head = sub >> 1, half = sub & 1;
        const bool halo = s0 + 64 < SEQ; const int th = halo ? 64 + (tid >> 3 & 15) : tt; const bf16* uh = (const bf16*)(ws + WS_U) + (size_t)(tok0 + th) * INC;
        u32x4 wq[4], wkv[6], whk, whv;
#pragma unroll
        for (int q = 0; q < 4; ++q) wq[q] = *(const u32x4*)(ur + U_NQ + head * 64 + half * 32 + 8 * q);
#pragma unroll
        for (int j6 = 0; j6 < 6; ++j6) wkv[j6] = *(const u32x4*)(ur + U_NKV + j6 * 64 + 8 * sub);
        whk = *(const u32x4*)(uh + U_NKV + 8 * sub); whv = *(const u32x4*)(uh + U_NKV + 64 + 8 * sub);
        const unsigned wg_ = *(const unsigned*)(ur + U_NG + 2 * (sub < 6 ? sub : 0));
        const f32x4 c0v = *(const f32x4*)(cosn + s * 8), c1v = *(const f32x4*)(cosn + s * 8 + 4), n0v = *(const f32x4*)(sinn + s * 8), n1v = *(const f32x4*)(sinn + s * 8 + 4);
        const int sh = s0 + th; const f32x4 hc0 = *(const f32x4*)(cosn + sh * 8), hc1 = *(const f32x4*)(cosn + sh * 8 + 4), hn0 = *(const f32x4*)(sinn + sh * 8), hn1 = *(const f32x4*)(sinn + sh * 8 + 4);
        const float cs[8] = {c0v.x, c0v.y, c0v.z, c0v.w, c1v.x, c1v.y, c1v.z, c1v.w}, sn[8] = {n0v.x, n0v.y, n0v.z, n0v.w, n1v.x, n1v.y, n1v.z, n1v.w};
        {
            float v[32];
#pragma unroll
            for (int q = 0; q < 4; ++q) { const unsigned ww[4] = {wq[q].x, wq[q].y, wq[q].z, wq[q].w};
#pragma unroll
                for (int j = 0; j < 4; ++j) { v[8 * q + 2 * j] = lo_bf(ww[j]); v[8 * q + 2 * j + 1] = hi_bf(ww[j]); } }
            if (half == 0) {
#pragma unroll
                for (int i = 0; i < 8; ++i) { const float x1 = v[i], x2 = v[i + 8]; v[i] = x1 * cs[i] - x2 * sn[i]; v[i + 8] = x2 * cs[i] + x1 * sn[i]; } }
            bf16* qo = (bf16*)(ws + WS_NQ) + (size_t)tok * 256 + head * 64 + half * 32;
#pragma unroll
            for (int q = 0; q < 4; ++q) { u32x4 o; o.x = pk2(v[8 * q] * NSA_QS, v[8 * q + 1] * NSA_QS); o.y = pk2(v[8 * q + 2] * NSA_QS, v[8 * q + 3] * NSA_QS);
                o.z = pk2(v[8 * q + 4] * NSA_QS, v[8 * q + 5] * NSA_QS); o.w = pk2(v[8 * q + 6] * NSA_QS, v[8 * q + 7] * NSA_QS); *(u32x4*)(qo + 8 * q) = o; }
        }
#pragma unroll
        for (int j6 = 0; j6 < 6; ++j6) {
            const unsigned ww[4] = {wkv[j6].x, wkv[j6].y, wkv[j6].z, wkv[j6].w}; float v[8];
#pragma unroll
            for (int j = 0; j < 4; ++j) { v[2 * j] = lo_bf(ww[j]); v[2 * j + 1] = hi_bf(ww[j]); }
            if ((j6 & 1) == 0) {
#pragma unroll
                for (int i = 0; i < 8; ++i) { const float other = __shfl_xor(v[i], 1); if (sub == 0) v[i] = v[i] * cs[i] - other * sn[i]; else if (sub == 1) v[i] = v[i] * cs[i] + other * sn[i]; }
            }
            if (j6 == 2 || j6 == 4) {
                float kss = 0.f;
#pragma unroll
                for (int j = 0; j < 8; ++j) kss += v[j] * v[j];
                kss += __shfl_xor(kss, 1); kss += __shfl_xor(kss, 2); kss += __shfl_xor(kss, 4);
                kss = fmaxf(kss, __shfl_xor(kss, 8)); kss = fmaxf(kss, __shfl_xor(kss, 16)); kss = fmaxf(kss, __shfl_xor(kss, 32));
                if (lane == 0) kmax_update((LAS unsigned*)(lds + LDS_MISC + 64), (j6 == 2 ? 72 : 80) + b, kss); }
            u32x4 o; o.x = pk2(v[0], v[1]); o.y = pk2(v[2], v[3]); o.z = pk2(v[4], v[5]); o.w = pk2(v[6], v[7]);
            if (j6 == 0) *(LAS u32x4*)(Kc + tt * 72 + 8 * sub) = o;
            else if (j6 == 1) *(LAS u32x4*)(Vc + tt * 72 + 8 * sub) = o;
            else if (j6 == 2) *(u32x4*)((bf16*)(ws + WS_NKS) + (size_t)tok * 64 + 8 * sub) = o;
            else if (j6 == 4) *(u32x4*)((bf16*)(ws + WS_NKW) + (size_t)tok * 64 + 8 * sub) = o;
            else { bf16* vt = (bf16*)(ws + (j6 == 3 ? WS_NVTS : WS_NVTW)) + ((size_t)b * 64 + 8 * sub) * SEQ + perm16pos(s);
#pragma unroll
                for (int j = 0; j < 8; ++j) vt[(size_t)j * SEQ] = (bf16)f2bf(v[j]); }
        }
        if (sub < 6) { float* go = (float*)(ws + WS_NGATE) + (size_t)tok * 12 + 2 * sub; go[0] = sigmoidf_(lo_bf(wg_)); go[1] = sigmoidf_(hi_bf(wg_)); }
        {
            const float hcs[8] = {hc0.x, hc0.y, hc0.z, hc0.w, hc1.x, hc1.y, hc1.z, hc1.w}, hsn[8] = {hn0.x, hn0.y, hn0.z, hn0.w, hn1.x, hn1.y, hn1.z, hn1.w};
            const unsigned wk4[4] = {whk.x, whk.y, whk.z, whk.w}; float v[8];
#pragma unroll
            for (int j = 0; j < 4; ++j) { v[2 * j] = lo_bf(wk4[j]); v[2 * j + 1] = hi_bf(wk4[j]); }
#pragma unroll
            for (int i = 0; i < 8; ++i) { const float other = __shfl_xor(v[i], 1); if (sub == 0) v[i] = v[i] * hcs[i] - other * hsn[i]; else if (sub == 1) v[i] = v[i] * hcs[i] + other * hsn[i]; }
            if (halo && tid < 128) { u32x4 o; o.x = pk2(v[0], v[1]); o.y = pk2(v[2], v[3]); o.z = pk2(v[4], v[5]); o.w = pk2(v[6], v[7]); *(LAS u32x4*)(Kc + th * 72 + 8 * sub) = o; *(LAS u32x4*)(Vc + th * 72 + 8 * sub) = whv; }
        }
    }
    WG_BAR();
    {
        const int kv = wid & 1, ob = wid >> 1, col = lane & 15, kq = lane >> 4, nl = col & 3;
        const LAS bf16* X = kv ? Vc : Kc;
        f32x4 acc = {0.f, 0.f, 0.f, 0.f};
#pragma unroll
        for (int c8 = 0; c8 < 8; ++c8) {
            if (c8 + 1 < 8) {
#pragma unroll
                for (int j = 0; j < 8; ++j) cwf[(c8 + 1) & 1][j] = *(const bf16x8*)(Wc_ + 32 * (8 * (c8 + 1) + j)); }
#pragma unroll
            for (int j = 0; j < 8; ++j) { const int ks = 8 * c8 + j, kk = 32 * ks + 8 * kq;
                const bf16x8 bx = *(const LAS bf16x8*)(X + (16 * nl + (kk >> 6)) * 72 + (kk & 63));
                acc = MFMA16(cwf[c8 & 1][j], bx, acc); } }
        if (col < 4) { const int n = s0 / 16 + nl, o0 = 16 * ob + 4 * kq; const bool real = n < 511; const f32x4 bias = *(const f32x4*)((const float*)(ws + WS_BIASC) + (l * 2 + kv) * 64 + o0);
            const f32x4 r = real ? acc + bias : (f32x4){0.f, 0.f, 0.f, 0.f};
            if (kv == 0) { u32x2 w; w.x = pk2(r.x, r.y); w.y = pk2(r.z, r.w); *(u32x2*)((bf16*)(ws + WS_NKC) + ((size_t)b * 512 + n) * 64 + o0) = w; }
            else { bf16* vt = (bf16*)(ws + WS_NVCT) + ((size_t)b * 64 + o0) * 512 + perm16pos(n); vt[0] = (bf16)f2bf(r.x); vt[512] = (bf16)f2bf(r.y); vt[1024] = (bf16)f2bf(r.z); vt[1536] = (bf16)f2bf(r.w); } }
    }
    WG_BAR();
}
#ifndef REP_CMP
#define REP_CMP 1
#endif
#ifndef REP_SEL
#define REP_SEL 1
#endif
#ifndef REP_WIN
#define REP_WIN 1
#endif
#ifndef REP_TOPK
#define REP_TOPK 1
#endif
struct SelMask { static constexpr bool ACTIVE = true; bool sel; int lim; __device__ __forceinline__ bool operator()(int k) const { return sel && k <= lim; } };
struct WinMask { static constexpr bool ACTIVE = true; int lo, hi_; __device__ __forceinline__ bool operator()(int k) const { return k > lo && k <= hi_; } };
__device__ __forceinline__ int next_bit4(unsigned m0, unsigned m1, unsigned m2, unsigned m3, int from) {
    for (int w = from >> 5; w < 4; ++w) { unsigned m = (w == 0 ? m0 : w == 1 ? m1 : w == 2 ? m2 : m3); if (w == (from >> 5)) m &= ~0u << (from & 31); if (m) return 32 * w + __builtin_ctz(m); }
    return 128;
}
__device__ __forceinline__ float dpp_x1(float x) { return __uint_as_float((unsigned)__builtin_amdgcn_update_dpp(0, (int)__float_as_uint(x), 0xB1, 0xf, 0xf, true)); }
__device__ __forceinline__ float dpp_x2(float x) { return __uint_as_float((unsigned)__builtin_amdgcn_update_dpp(0, (int)__float_as_uint(x), 0x4E, 0xf, 0xf, true)); }
__device__ __forceinline__ float dpp_hm(float x) { return __uint_as_float((unsigned)__builtin_amdgcn_update_dpp(0, (int)__float_as_uint(x), 0x141, 0xf, 0xf, true)); }
__device__ __forceinline__ int dpp_x1(int x) { return __builtin_amdgcn_update_dpp(0, x, 0xB1, 0xf, 0xf, true); }
__device__ __forceinline__ int dpp_x2(int x) { return __builtin_amdgcn_update_dpp(0, x, 0x4E, 0xf, 0xf, true); }
__device__ __forceinline__ int dpp_hm(int x) { return __builtin_amdgcn_update_dpp(0, x, 0x141, 0xf, 0xf, true); }
__device__ __forceinline__ void nsa_unit(const Args& A, int l, int unit, LAS unsigned char* lds) {
    unsigned char* ws = A.ws;
    int tid = threadIdx.x; asm volatile("" : "+v"(tid));
    const int lane = tid & 63, wid = __builtin_amdgcn_readfirstlane(tid >> 6), r32 = lane & 31, hi = lane >> 5;
    const int b = unit >> 7, qblk = unit & 127, q0 = qblk * 64, cur = qblk;
    if (wid >= 4) __builtin_amdgcn_s_setprio(1);
    constexpr int LD = 72, TB = 64 * LD * 2;
    LAS float* IMP = (LAS float*)(lds + 4 * TB);
    LAS unsigned* SELM = (LAS unsigned*)(lds + 4 * TB + 32768);
    LAS unsigned* UNI = SELM + 256;
    LAS float* OUT = (LAS float*)(lds + 4 * TB + 32768 + 2048) + tid;
    const int ql = 8 * wid + (r32 >> 2), head = r32 & 3, qpos = q0 + ql; const size_t tok = (size_t)b * SEQ + qpos;
    bf16x8 qf[4];
#pragma unroll
    for (int d0 = 0; d0 < 4; ++d0) qf[d0] = *(const bf16x8*)((const bf16*)(ws + WS_NQ) + tok * 256 + head * 64 + 16 * d0 + 8 * hi);
    const float* gt = (const float*)(ws + WS_NGATE) + tok * 12 + head * 3; const float g_c = gt[0], g_s = gt[1], g_w = gt[2];
    const int ldn = tid >> 3, ldc = tid & 7;
    u32x4 rk, rv;
#define NSA_LOAD(Kg, VTg, vstr, blk) do { rk = *(const u32x4*)((Kg) + (size_t)((blk) * 64 + ldn) * 64 + 8 * ldc); rv = *(const u32x4*)((VTg) + (size_t)ldn * (vstr) + (blk) * 64 + 8 * ldc); } while (0)
#define NSA_LOADK(Kg, blk) do { rk = *(const u32x4*)((Kg) + (size_t)((blk) * 64 + ldn) * 64 + 8 * ldc); } while (0)
#define NSA_STOREK(buf) do { *(LAS u32x4*)(lds + (buf) * 2 * TB + (ldn * LD + 8 * ldc) * 2) = rk; } while (0)
#define NSA_STORE(buf) do { *(LAS u32x4*)(lds + (buf) * 2 * TB + (ldn * LD + 8 * ldc) * 2) = rk; *(LAS u32x4*)(lds + (buf) * 2 * TB + TB + (ldn * LD + 8 * ldc) * 2) = rv; } while (0)
    const bf16* Kcg = (const bf16*)(ws + WS_NKC) + (size_t)b * 512 * 64; const bf16* VTcg = (const bf16*)(ws + WS_NVCT) + (size_t)b * 64 * 512;
    NSA_LOAD(Kcg, VTcg, 512, 0);
    float nref_s, nref_w; { const float q2 = qnorm2<4>(qf);
        nref_s = -(sqrtf(q2 * kmax_read(ws, l, 72 + b, lane, (int)gridDim.x)) * 1.02f + 0.25f); nref_w = -(sqrtf(q2 * kmax_read(ws, l, 80 + b, lane, (int)gridDim.x)) * 1.02f + 0.25f); }
    {
        const int ntc = (4 * qblk + 2) / 64 + 1; const int nlim = (qpos - 31) >> 4;
        for (int rep_ = 0; rep_ < REP_CMP; ++rep_) {
        float m = -1e30f, ls = 0.f;
        WG_BAR();
        for (int i = tid; i < 64 * 128 / 4; i += NTHR) ((LAS f32x4*)IMP)[i] = (f32x4){0.f, 0.f, 0.f, 0.f};
#pragma unroll
        for (int pass = 0; pass < 2; ++pass) {
            f32x16 oc[2] = {}; const float cexp = ls > 0.f ? -__builtin_amdgcn_logf(ls) - m : -INFINITY; int p = 0;
            if (pass | rep_) NSA_LOAD(Kcg, VTcg, 512, 0);
            if (pass) NSA_STORE(0); else NSA_STOREK(0);
            WG_BAR();
            for (int t = 0; t < ntc; ++t) {
                if (pass) NSA_LOAD(Kcg, VTcg, 512, (t + 1 < ntc ? t + 1 : t)); else NSA_LOADK(Kcg, (t + 1 < ntc ? t + 1 : t));
                const LAS bf16* Kt = (const LAS bf16*)(lds + p * 2 * TB); const LAS bf16* Vt = (const LAS bf16*)(lds + p * 2 * TB + TB);
                f32x16 s0 = {}, s1 = {};
#pragma unroll
                for (int d0 = 0; d0 < 4; ++d0) { const bf16x8 k0 = *(const LAS bf16x8*)(Kt + r32 * LD + 16 * d0 + 8 * hi), k1 = *(const LAS bf16x8*)(Kt + (32 + r32) * LD + 16 * d0 + 8 * hi);
                    s0 = MFMA32(k0, qf[d0], s0); s1 = MFMA32(k1, qf[d0], s1); }
#pragma unroll
                for (int r = 0; r < 16; ++r) { const int n = 64 * t + crow(r, hi); if (n > nlim) s0[r] = -INFINITY; if (n + 32 > nlim) s1[r] = -INFINITY; }
                if (pass == 0) {
                    float mx = fmaxf(s0[0], s1[0]);
#pragma unroll
                    for (int r = 1; r < 16; ++r) mx = fmaxf(mx, fmaxf(s0[r], s1[r]));
                    const float mn = fmaxf(m, mx); float ps = 0.f;
#pragma unroll
                    for (int r = 0; r < 16; ++r) ps += __builtin_amdgcn_exp2f(s0[r] - mn) + __builtin_amdgcn_exp2f(s1[r] - mn);
                    ls = ls * __builtin_amdgcn_exp2f(m - mn) + ps; m = mn;
                } else {
#pragma unroll
                    for (int r = 0; r < 16; ++r) { s0[r] = __builtin_amdgcn_exp2f(s0[r] + cexp); s1[r] = __builtin_amdgcn_exp2f(s1[r] + cexp); }
#pragma unroll
                    for (int blk = 0; blk < 2; ++blk)
#pragma unroll
                        for (int g = 0; g < 4; ++g) { float e = blk ? s1[4 * g + 3] : s0[4 * g + 3]; float gs = blk ? (s1[4 * g] + s1[4 * g + 1]) + (s1[4 * g + 2] + e) : (s0[4 * g] + s0[4 * g + 1]) + (s0[4 * g + 2] + e);
                            gs += dpp_x1(gs); gs += dpp_x2(gs); e += dpp_x1(e); e += dpp_x2(e);
                            const int j = 16 * t + 8 * blk + 2 * g + hi;
                            if (head == 0) { __hip_atomic_fetch_add(&IMP[ql * 128 + j], gs, __ATOMIC_RELAXED, __HIP_MEMORY_SCOPE_WORKGROUP); if (j + 1 < 128) __hip_atomic_fetch_add(&IMP[ql * 128 + j + 1], e, __ATOMIC_RELAXED, __HIP_MEMORY_SCOPE_WORKGROUP); } }
                    bf16x8 pk[4];
#pragma unroll
                    for (int sp = 0; sp < 4; ++sp) { u32x4 w;
                        if (sp < 2) { w.x = pk2(s0[8 * sp + 0], s0[8 * sp + 1]); w.y = pk2(s0[8 * sp + 2], s0[8 * sp + 3]); w.z = pk2(s0[8 * sp + 4], s0[8 * sp + 5]); w.w = pk2(s0[8 * sp + 6], s0[8 * sp + 7]); }
                        else { const int q = sp - 2; w.x = pk2(s1[8 * q + 0], s1[8 * q + 1]); w.y = pk2(s1[8 * q + 2], s1[8 * q + 3]); w.z = pk2(s1[8 * q + 4], s1[8 * q + 5]); w.w = pk2(s1[8 * q + 6], s1[8 * q + 7]); }
                        pk[sp] = __builtin_bit_cast(bf16x8, w); }
#pragma unroll
                    for (int db = 0; db < 2; ++db)
#pragma unroll
                        for (int sp = 0; sp < 4; ++sp) { const bf16x8 a = *(const LAS bf16x8*)(Vt + (32 * db + r32) * LD + 16 * sp + 8 * hi); oc[db] = MFMA32(a, pk[sp], oc[db]); }
                }
                if (pass) NSA_STORE(p ^ 1); else NSA_STOREK(p ^ 1);
                WG_BAR();
                p ^= 1;
            }
            if (pass == 0) { const float mo = __shfl_xor(m, 32), M = fmaxf(m, mo);
                ls *= __builtin_amdgcn_exp2f(m - M); ls += __shfl_xor(ls, 32); m = M; }
            else {
#pragma unroll
                for (int r = 0; r < 16; ++r) { OUT[r * NTHR] = oc[0][r] * g_c; OUT[(16 + r) * NTHR] = oc[1][r] * g_c; } }
        }
        }
    }
    {
        const int tq = tid >> 3, sub = tid & 7; unsigned mk0 = 0u, mk1 = 0u, mk2 = 0u, mk3 = 0u;
        for (int rep_ = 0; rep_ < REP_TOPK; ++rep_) { mk0 = mk1 = mk2 = mk3 = 0u; asm volatile("" : "+v"(mk0));
#define NSA_SETBIT(jj) do { const int j_ = (jj); const unsigned bit_ = 1u << (j_ & 31); const int w_ = j_ >> 5; mk0 |= (w_ == 0) ? bit_ : 0u; mk1 |= (w_ == 1) ? bit_ : 0u; mk2 |= (w_ == 2) ? bit_ : 0u; mk3 |= (w_ == 3) ? bit_ : 0u; } while (0)
        if (cur < 16) { for (int j = 0; j <= cur; ++j) NSA_SETBIT(j); }
        else {
            NSA_SETBIT(0); NSA_SETBIT(cur); NSA_SETBIT(cur - 1);
            float v[16];
#pragma unroll
            for (int i = 0; i < 16; ++i) { const int j = sub * 16 + i; v[i] = (j <= cur && j != 0 && j != cur && j != cur - 1) ? IMP[tq * 128 + j] : -INFINITY; }
            for (int round = 0; round < 13; ++round) {
                float bv = v[0]; int bj = sub * 16;
#pragma unroll
                for (int i = 1; i < 16; ++i) if (v[i] > bv) { bv = v[i]; bj = sub * 16 + i; }
#pragma unroll
                for (int o = 0; o < 3; ++o) { const float ov = o == 0 ? dpp_x1(bv) : o == 1 ? dpp_x2(bv) : dpp_hm(bv); const int oj = o == 0 ? dpp_x1(bj) : o == 1 ? dpp_x2(bj) : dpp_hm(bj);
                    if (ov > bv || (ov == bv && oj < bj)) { bv = ov; bj = oj; } }
                NSA_SETBIT(bj);
#pragma unroll
                for (int i = 0; i < 16; ++i) if (bj == sub * 16 + i) v[i] = -INFINITY;
            }
        }
        }
#undef NSA_SETBIT
        if (sub == 0) { SELM[tq * 4 + 0] = mk0; SELM[tq * 4 + 1] = mk1; SELM[tq * 4 + 2] = mk2; SELM[tq * 4 + 3] = mk3; }
        WG_BAR();
    }
    const bf16* Ks = (const bf16*)(ws + WS_NKS) + (size_t)(b * SEQ) * 64; const bf16* VTs = (const bf16*)(ws + WS_NVTS) + (size_t)(b * 64) * SEQ;
    const bf16* Kw = (const bf16*)(ws + WS_NKW) + (size_t)(b * SEQ) * 64; const bf16* VTw = (const bf16*)(ws + WS_NVTW) + (size_t)(b * 64) * SEQ;
    {
        const unsigned sq0 = SELM[ql * 4], sq1 = SELM[ql * 4 + 1], sq2 = SELM[ql * 4 + 2], sq3 = SELM[ql * 4 + 3];
        unsigned w0 = sq0, w1 = sq1, w2 = sq2, w3 = sq3;
#pragma unroll
        for (int o_ = 4; o_ < 64; o_ <<= 1) { w0 |= __shfl_xor(w0, o_); w1 |= __shfl_xor(w1, o_); w2 |= __shfl_xor(w2, o_); w3 |= __shfl_xor(w3, o_); }
        const unsigned u0 = __builtin_amdgcn_readfirstlane(w0), u1 = __builtin_amdgcn_readfirstlane(w1), u2 = __builtin_amdgcn_readfirstlane(w2), u3 = __builtin_amdgcn_readfirstlane(w3);
        f32x16 o[2] = {}; float ls = 0.f;
        for (int rep_ = 0; rep_ < REP_SEL; ++rep_) { o[0] = f32x16{}; o[1] = f32x16{}; ls = 0.f; asm volatile("" : "+v"(ls));
        u32x4 rka, rva, rkb, rvb;
#define SEL_LOAD(RK, RV, blk) do { const int b_ = (blk) <= cur ? (blk) : cur; RK = *(const u32x4*)(Ks + (size_t)(b_ * 64 + ldn) * 64 + 8 * ldc); RV = *(const u32x4*)(VTs + (size_t)ldn * SEQ + b_ * 64 + 8 * ldc); } while (0)
#define SEL_STORE(RK, RV, buf) do { *(LAS u32x4*)(lds + (buf) * 2 * TB + (ldn * LD + 8 * ldc) * 2) = RK; *(LAS u32x4*)(lds + (buf) * 2 * TB + TB + (ldn * LD + 8 * ldc) * 2) = RV; } while (0)
#define SEL_STEP(j, buf) do { const unsigned uw_ = ((j) >> 5) == 0 ? u0 : ((j) >> 5) == 1 ? u1 : ((j) >> 5) == 2 ? u2 : u3; \
            if ((uw_ >> ((j) & 31)) & 1u) { const unsigned sw_ = ((j) >> 5) == 0 ? sq0 : ((j) >> 5) == 1 ? sq1 : ((j) >> 5) == 2 ? sq2 : sq3; const bool sel_ = (sw_ >> ((j) & 31)) & 1u; \
                if ((j) == cur) flash_step_fx<64, 64, SelMask, const LAS bf16*>((const LAS bf16*)(lds + (buf) * 2 * TB), LD, (const LAS bf16*)(lds + (buf) * 2 * TB + TB), LD, qf, o, nref_s, ls, SelMask{sel_, ql}, r32, hi); \
                else flash_step_fx<64, 64, NoMask, const LAS bf16*>((const LAS bf16*)(lds + (buf) * 2 * TB), LD, (const LAS bf16*)(lds + (buf) * 2 * TB + TB), LD, qf, o, nref_s, ls, NoMask{}, r32, hi, sel_); } } while (0)
        SEL_LOAD(rka, rva, 0); SEL_STORE(rka, rva, 0);
        SEL_LOAD(rkb, rvb, 1);
        WG_BAR();
        for (int j = 0; j <= cur; j += 2) {
            SEL_LOAD(rka, rva, j + 2);
            SEL_STEP(j, 0);
            SEL_STORE(rkb, rvb, 1);
            WG_BAR();
            if (j + 1 > cur) break;
            SEL_LOAD(rkb, rvb, j + 3);
            SEL_STEP(j + 1, 1);
            SEL_STORE(rka, rva, 0);
            WG_BAR();
        }
#undef SEL_LOAD
#undef SEL_STORE
#undef SEL_STEP
        }
        ls += __shfl_xor(ls, 32); const float sc = g_s / ls;
#pragma unroll
        for (int r = 0; r < 16; ++r) { OUT[r * NTHR] += o[0][r] * sc; OUT[(16 + r) * NTHR] += o[1][r] * sc; }
    }
    WG_BAR();
    f32x16 tot[2];
    {
        f32x16 o[2] = {}; float ls = 0.f;
        const int kt0 = qblk >= 8 ? qblk - 8 : 0; int p = 0;
        for (int rep_ = 0; rep_ < REP_WIN; ++rep_) { o[0] = f32x16{}; o[1] = f32x16{}; ls = 0.f; p = 0; asm volatile("" : "+v"(ls));
        NSA_LOAD(Kw, VTw, SEQ, kt0); NSA_STORE(0);
        WG_BAR();
        for (int kt = kt0; kt <= qblk; ++kt) {
            NSA_LOAD(Kw, VTw, SEQ, (kt < qblk ? kt + 1 : qblk));
            const LAS bf16* Kt = (const LAS bf16*)(lds + p * 2 * TB); const LAS bf16* Vt = (const LAS bf16*)(lds + p * 2 * TB + TB);
            if (kt == qblk) flash_step_fx<64, 64, WinMask, const LAS bf16*>(Kt, LD, Vt, LD, qf, o, nref_w, ls, WinMask{-1, ql}, r32, hi);
            else if (kt == qblk - 8) flash_step_fx<64, 64, WinMask, const LAS bf16*>(Kt, LD, Vt, LD, qf, o, nref_w, ls, WinMask{ql, 63}, r32, hi);
            else flash_step_fx<64, 64, NoMask, const LAS bf16*>(Kt, LD, Vt, LD, qf, o, nref_w, ls, NoMask{}, r32, hi);
            NSA_STORE(p ^ 1);
            WG_BAR();
            p ^= 1;
        } }
        ls += __shfl_xor(ls, 32); const float sc = g_w / ls;
#pragma unroll
        for (int r = 0; r < 16; ++r) { tot[0][r] = OUT[r * NTHR] + o[0][r] * sc; tot[1][r] = OUT[(16 + r) * NTHR] + o[1][r] * sc; }
    }
#undef NSA_LOAD
#undef NSA_STORE
#undef NSA_LOADK
#undef NSA_STOREK
    __builtin_amdgcn_s_setprio(0);
    {
        float ss = 0.f;
#pragma unroll
        for (int r = 0; r < 16; ++r) ss += tot[0][r] * tot[0][r] + tot[1][r] * tot[1][r];
        ss += __shfl_xor(ss, 1); ss += __shfl_xor(ss, 2); ss += __shfl_xor(ss, 32);
        const float rs = __builtin_amdgcn_rsqf(ss * (1.f / 256.f) + EPS);
        bf16* yr = (bf16*)(ws + WS_Y) + tok * D + 256 + head * 64; const float* gn = INF(I_GNORM) + (size_t)(l * 4 + 1) * 256 + head * 64;
        f32x4 g8[2][4];
#pragma unroll
        for (int db = 0; db < 2; ++db)
#pragma unroll
            for (int r4 = 0; r4 < 4; ++r4) g8[db][r4] = *(const f32x4*)(gn + 32 * db + 8 * r4 + 4 * hi);
        __builtin_amdgcn_sched_barrier(0);
#pragma unroll
        for (int db = 0; db < 2; ++db)
#pragma unroll
            for (int r4 = 0; r4 < 4; ++r4) { const int d = 32 * db + 8 * r4 + 4 * hi; const f32x4 g4 = g8[db][r4];
                u32x2 w; w.x = pk2(tot[db][4 * r4] * rs * g4.x, tot[db][4 * r4 + 1] * rs * g4.y); w.y = pk2(tot[db][4 * r4 + 2] * rs * g4.z, tot[db][4 * r4 + 3] * rs * g4.w);
                *(u32x2*)(yr + d) = w; }
    }
    WG_BAR();
}

constexpr size_t WS_MWGU = WS_ARENA;
constexpr size_t WS_MWD = 100 * MiB;
constexpr size_t WS_HPERM = 130 * MiB;
constexpr size_t WS_MHN8 = 198 * MiB;
constexpr size_t WS_MACT = 198 * MiB;
constexpr size_t WS_Y1 = 318 * MiB;
constexpr size_t WS_PARKB = 450 * MiB;
constexpr size_t WS_TOKINFO = 454 * MiB;
constexpr size_t WS_ROWTOK = 455 * MiB;
constexpr size_t WS_ROWW = WS_ROWTOK + 512 * 1024;
constexpr size_t WS_POS1 = 456 * MiB;
constexpr size_t WS_TILEE = WS_POS1 + 256 * 1024;
constexpr int MAXROWS = 67584, CW_MOE = 12288;
static_assert(WS_MWGU + (size_t)8 * 2 * DFF * D <= WS_MWD && WS_MWD + (size_t)8 * D * DFF <= WS_HPERM && WS_HPERM + (size_t)MAXROWS * D <= WS_MACT && WS_MACT + (size_t)34816 * DFF <= WS_Y1 && WS_Y1 + (size_t)MAXROWS * D * 2 <= WS_PARKB && WS_TILEE + 4096 <= WS_END, "moe map");

namespace pg8 {
struct MoeOrder : StaticOrder { const int* tile_e; int tile0; size_t estride;
    __device__ __forceinline__ size_t bofs(const Unit& u) const { return (size_t)tile_e[tile0 + u.pm] * estride; } };
struct TailOrder { static constexpr bool ROT = false; __device__ __forceinline__ int krot(const Unit&) const { return 0; } const int* tile_e; int tile0, ntl, G, c; size_t estride;
    __device__ __forceinline__ bool next(int i, Unit& u) const { const long L = (long)i * G + c; if (L >= (long)ntl * 8) return false; u.pm = (int)(L >> 3); u.pn = (int)(L >> 1) & 3; u.ks = (int)L & 1; return true; }
    __device__ __forceinline__ void a_ready(const Unit&) const {}
    __device__ __forceinline__ void done(const Unit&) const {}
    __device__ __forceinline__ size_t bofs(const Unit& u) const { return (size_t)tile_e[tile0 + u.pm] * estride; } };
struct EpiMoeDown {
    static constexpr bool PERM = false, AFTER_DRAIN = false, IDEM = false;
    const int* rowtok; const float* roww; bf16_t* parkb; bf16_t* hperm; int row0g; float scale;
    __device__ __forceinline__ void operator()(const f32x4 (&acc)[2][2][4][2], const Unit& u, int wr, int wc, int fr, int fq) const {
        const int col0 = u.pn * BM + wc * 32 + 4 * fq;
        int tiv[2][4]; float wv[2][4];
#pragma unroll
        for (int ai = 0; ai < 2; ++ai)
#pragma unroll
            for (int m = 0; m < 4; ++m) { const int grow = row0g + u.pm * BM + ai * HALF + wr * 64 + m * 16 + fr; tiv[ai][m] = rowtok[grow]; wv[ai][m] = roww[grow]; }
        __builtin_amdgcn_sched_barrier(0);
#pragma unroll
        for (int ai = 0; ai < 2; ++ai)
#pragma unroll
            for (int m = 0; m < 4; ++m) { const int grow = row0g + u.pm * BM + ai * HALF + wr * 64 + m * 16 + fr; const int ti = tiv[ai][m]; const float w = wv[ai][m] * scale;
                if (ti >= 0) { bf16_t* rp = (u.ks ? parkb + (size_t)(grow - 65536) * 1024 : hperm + (size_t)grow * 1024) + col0;
#pragma unroll
                    for (int bj = 0; bj < 2; ++bj)
#pragma unroll
                        for (int n = 0; n < 2; ++n) { const f32x4 v = acc[ai][bj][m][n] * w; u32x2 o; o.x = cvt_pk_bf16(v[0], v[1]); o.y = cvt_pk_bf16(v[2], v[3]); *(u32x2*)(rp + bj * HALF + n * 16) = o; } } }
    }
};
}

__device__ __forceinline__ void moe_router_rows(const Args& A, LAS unsigned char* lds, int gw, int ngw, int wave, int lane) {
    unsigned char* ws = A.ws; const float* X = A.out; const float* g = INF(I_NORM_FFN) + D; const float* R = INF(I_MOE_R); unsigned* cnt = (unsigned*)(ws + WS_CTL) + CW_MOE;
    LAS unsigned* lcnt = (LAS unsigned*)lds;
    LAS int* rinfo = (LAS int*)(lds + 64);
    if (threadIdx.x < 16) lcnt[threadIdx.x] = 0u;
    __syncthreads();
    int slot = 0;
    f32x4 gr_[4][4][2];
#pragma unroll
    for (int j = 0; j < 4; ++j) { const f32x4 gg = ((const f32x4*)g + lane)[64 * j]; const float gv[4] = {gg.x, gg.y, gg.z, gg.w};
#pragma unroll
        for (int i = 0; i < 4; ++i) { const f32x4* rr = (const f32x4*)(R + (size_t)(256 * j + 4 * lane + i) * 8); gr_[j][i][0] = rr[0] * gv[i]; gr_[j][i][1] = rr[1] * gv[i]; } }
    const bool b0 = lane & 1, b1 = lane & 2, b2 = lane & 4;
    f32x4 gq[4];
#pragma unroll
    for (int j = 0; j < 4; ++j) gq[j] = ((const f32x4*)g + lane)[64 * j];
    unsigned char* hn8 = ws + WS_MHN8;
    for (int m = gw; m < T; m += ngw, ++slot) {
        const f32x4* xr = (const f32x4*)(X + (size_t)m * D) + lane;
        f32x4 v[4]; float s = 0.f;
#pragma unroll
        for (int j = 0; j < 4; ++j) { v[j] = xr[64 * j]; s += (v[j].x * v[j].x + v[j].y * v[j].y) + (v[j].z * v[j].z + v[j].w * v[j].w); }
        float lg[8] = {0.f, 0.f, 0.f, 0.f, 0.f, 0.f, 0.f, 0.f};
#pragma unroll
        for (int j = 0; j < 4; ++j) { const float hh[4] = {v[j].x, v[j].y, v[j].z, v[j].w};
#pragma unroll
            for (int i = 0; i < 4; ++i) { const f32x4 r0 = gr_[j][i][0], r1 = gr_[j][i][1];
                lg[0] += hh[i] * r0.x; lg[1] += hh[i] * r0.y; lg[2] += hh[i] * r0.z; lg[3] += hh[i] * r0.w; lg[4] += hh[i] * r1.x; lg[5] += hh[i] * r1.y; lg[6] += hh[i] * r1.z; lg[7] += hh[i] * r1.w; } }
        const float rs = __builtin_amdgcn_rsqf(wave_sum(s) * (1.f / D) + EPS);
        { const float r8 = rs * F8_H; unsigned* o4 = (unsigned*)(hn8 + (size_t)m * D) + lane;
#pragma unroll
          for (int j = 0; j < 4; ++j) o4[64 * j] = pk4_fp8(clamp8(v[j].x * r8 * gq[j].x), clamp8(v[j].y * r8 * gq[j].y), clamp8(v[j].z * r8 * gq[j].z), clamp8(v[j].w * r8 * gq[j].w)); }
        float a4[4], c2[2], d1;
#pragma unroll
        for (int k = 0; k < 4; ++k) { const float snd = b0 ? lg[k] : lg[4 + k], kp = b0 ? lg[4 + k] : lg[k]; a4[k] = kp + __shfl_xor(snd, 1); }
#pragma unroll
        for (int k = 0; k < 2; ++k) { const float snd = b1 ? a4[k] : a4[2 + k], kp = b1 ? a4[2 + k] : a4[k]; c2[k] = kp + __shfl_xor(snd, 2); }
        { const float snd = b2 ? c2[0] : c2[1], kp = b2 ? c2[1] : c2[0]; d1 = kp + __shfl_xor(snd, 4); }
        d1 += __shfl_xor(d1, 8); d1 += __shfl_xor(d1, 16); d1 += __shfl_xor(d1, 32);
        d1 *= rs;
        { const int di = (int)__float_as_uint(d1);
          lg[0] = __uint_as_float((unsigned)__builtin_amdgcn_readlane(di, 0)); lg[1] = __uint_as_float((unsigned)__builtin_amdgcn_readlane(di, 4)); lg[2] = __uint_as_float((unsigned)__builtin_amdgcn_readlane(di, 2)); lg[3] = __uint_as_float((unsigned)__builtin_amdgcn_readlane(di, 6));
          lg[4] = __uint_as_float((unsigned)__builtin_amdgcn_readlane(di, 1)); lg[5] = __uint_as_float((unsigned)__builtin_amdgcn_readlane(di, 5)); lg[6] = __uint_as_float((unsigned)__builtin_amdgcn_readlane(di, 3)); lg[7] = __uint_as_float((unsigned)__builtin_amdgcn_readlane(di, 7)); }
        int e1 = 0; float v1 = lg[0];
#pragma unroll
        for (int e = 1; e < 8; ++e) if (lg[e] > v1) { v1 = lg[e]; e1 = e; }
        int e2 = -1; float v2 = -INFINITY;
#pragma unroll
        for (int e = 0; e < 8; ++e) if (e != e1 && lg[e] > v2) { v2 = lg[e]; e2 = e; }
        if (lane == 0) { const float w1 = 1.0f / (1.0f + __expf(v2 - v1));
            const int r1 = (int)__hip_atomic_fetch_add(lcnt + e1, 1u, __ATOMIC_RELAXED, __HIP_MEMORY_SCOPE_WORKGROUP), r2 = (int)__hip_atomic_fetch_add(lcnt + e2, 1u, __ATOMIC_RELAXED, __HIP_MEMORY_SCOPE_WORKGROUP);
            LAS int* ri = rinfo + (wave * 32 + slot) * 5; ri[0] = e1; ri[1] = e2; ri[2] = r1; ri[3] = r2; ri[4] = (int)__float_as_uint(w1); }
    }
    __syncthreads();
    if (threadIdx.x < 8) lcnt[8 + threadIdx.x] = atomicAdd(&cnt[threadIdx.x], lcnt[threadIdx.x]);
    __syncthreads();
    if (lane == 0) { slot = 0;
        for (int m = gw; m < T; m += ngw, ++slot) { const LAS int* ri = rinfo + (wave * 32 + slot) * 5; const int e1 = ri[0], e2 = ri[1]; const float w1 = __uint_as_float((unsigned)ri[4]);
            int* ti = (int*)(ws + WS_TOKINFO) + (size_t)m * 8; ti[0] = e1; ti[1] = e2; ti[2] = (int)lcnt[8 + e1] + ri[2]; ti[3] = (int)lcnt[8 + e2] + ri[3]; ((float*)ti)[4] = w1; ((float*)ti)[5] = 1.0f - w1; } }
    __syncthreads();
}
__device__ __forceinline__ void moe_permute_rows(const Args& A, int gw, int ngw, int lane) {
    unsigned char* ws = A.ws; const float* X = A.out; const float* g = INF(I_NORM_FFN) + D; const unsigned* cnt = (const unsigned*)(ws + WS_CTL) + CW_MOE;
    int off[9]; off[0] = 0;
#pragma unroll
    for (int e = 0; e < 8; ++e) { const int c = (int)cnt[e]; off[e + 1] = off[e] + ((c + 255) & ~255); }
    int* rowtok = (int*)(ws + WS_ROWTOK); float* roww = (float*)(ws + WS_ROWW); int* pos1 = (int*)(ws + WS_POS1); unsigned char* hp = ws + WS_HPERM;
    if (gw == 0) {
        int* te = (int*)(ws + WS_TILEE); const int ntile = off[8] >> 8;
        for (int t = lane; t < ntile; t += 64) { int e = 0;
#pragma unroll
            for (int k = 1; k < 8; ++k) if (t * 256 >= off[k]) e = k;
            te[t] = e; }
        if (lane == 0) te[511] = ntile;
#pragma unroll
        for (int e = 0; e < 8; ++e) { const int c = (int)cnt[e]; for (int r = off[e] + c + lane; r < off[e + 1]; r += 64) rowtok[r] = -1; }
    }
    for (int m = gw; m < T; m += 2 * ngw) {
        const int mr[2] = {m, m + ngw < T ? m + ngw : m};
        int e1[2], e2[2], r1[2], r2[2]; float w1[2], w2[2];
#pragma unroll
        for (int q = 0; q < 2; ++q) { const int* ti = (const int*)(ws + WS_TOKINFO) + (size_t)mr[q] * 8; e1[q] = ti[0]; e2[q] = ti[1]; r1[q] = ti[2]; r2[q] = ti[3]; w1[q] = ((const float*)ti)[4]; w2[q] = ((const float*)ti)[5]; }
        unsigned w4[2][4];
#pragma unroll
        for (int q = 0; q < 2; ++q) { const unsigned* hr = (const unsigned*)(ws + WS_MHN8 + (size_t)mr[q] * D) + lane;
#pragma unroll
            for (int j = 0; j < 4; ++j) w4[q][j] = hr[64 * j]; }
#pragma unroll
        for (int q = 0; q < 2; ++q) { int p1 = 0, p2 = 0;
#pragma unroll
            for (int e = 0; e < 8; ++e) { if (e == e1[q]) p1 = off[e] + r1[q]; if (e == e2[q]) p2 = off[e] + r2[q]; }
            unsigned* o1 = (unsigned*)(hp + (size_t)p1 * D) + lane; unsigned* o2 = (unsigned*)(hp + (size_t)p2 * D) + lane;
#pragma unroll
            for (int j = 0; j < 4; ++j) { o1[64 * j] = w4[q][j]; o2[64 * j] = w4[q][j]; }
            if (lane == 0) { rowtok[p1] = mr[q]; roww[p1] = w1[q]; rowtok[p2] = mr[q] | (1 << 30); roww[p2] = w2[q]; pos1[2 * mr[q]] = p1; pos1[2 * mr[q] + 1] = p2; } }
    }
}
__device__ __forceinline__ void phase_final_norm_moe(const Args& A, int gw, int ngw, int lane) {
    unsigned char* ws = A.ws; float* X = A.out; const float* g = INF(I_NORM_FINAL); const int* pos1 = (const int*)(ws + WS_POS1); const bf16* hp = (const bf16*)(ws + WS_Y1); const bf16* pbk = (const bf16*)(ws + WS_PARKB);
    f32x4 ggv[4];
#pragma unroll
    for (int j = 0; j < 4; ++j) ggv[j] = ((const f32x4*)g + lane)[64 * j];
    int m = gw;
    constexpr int NR = 2;
    for (; m < T; m += NR * ngw) {
        int mr[NR]; bool ok[NR];
#pragma unroll
        for (int q = 0; q < NR; ++q) { ok[q] = m + q * ngw < T; mr[q] = ok[q] ? m + q * ngw : m; }
        int pa[NR], pb[NR];
#pragma unroll
        for (int q = 0; q < NR; ++q) { pa[q] = pos1[2 * mr[q]]; pb[q] = pos1[2 * mr[q] + 1]; }
        f32x4 v[NR][4]; u32x2 ya[NR][4], yb[NR][4];
#pragma unroll
        for (int q = 0; q < NR; ++q) { const f32x4* xr = (const f32x4*)(X + (size_t)mr[q] * D) + lane; const u32x2* pya = (const u32x2*)(hp + (size_t)pa[q] * D) + lane; const u32x2* pyb = (const u32x2*)(hp + (size_t)pb[q] * D) + lane;
#pragma unroll
            for (int j = 0; j < 4; ++j) { v[q][j] = xr[64 * j]; ya[q][j] = __builtin_nontemporal_load(pya + 64 * j); yb[q][j] = __builtin_nontemporal_load(pyb + 64 * j); } }
#pragma unroll
        for (int q = 0; q < NR; ++q) {
#pragma unroll
            for (int j = 0; j < 4; ++j) { const u32x2 y = ya[q][j], z = yb[q][j]; v[q][j].x += lo_bf(y.x) + lo_bf(z.x); v[q][j].y += hi_bf(y.x) + hi_bf(z.x); v[q][j].z += lo_bf(y.y) + lo_bf(z.y); v[q][j].w += hi_bf(y.y) + hi_bf(z.y); }
            if (pa[q] >= 65536) { const u32x2* yc = (const u32x2*)(pbk + (size_t)(pa[q] - 65536) * D) + lane;
#pragma unroll
                for (int j = 0; j < 4; ++j) { const u32x2 y = yc[64 * j]; v[q][j].x += lo_bf(y.x); v[q][j].y += hi_bf(y.x); v[q][j].z += lo_bf(y.y); v[q][j].w += hi_bf(y.y); } }
            if (pb[q] >= 65536) { const u32x2* yc = (const u32x2*)(pbk + (size_t)(pb[q] - 65536) * D) + lane;
#pragma unroll
                for (int j = 0; j < 4; ++j) { const u32x2 y = yc[64 * j]; v[q][j].x += lo_bf(y.x); v[q][j].y += hi_bf(y.x); v[q][j].z += lo_bf(y.y); v[q][j].w += hi_bf(y.y); } }
            float s = 0.f;
#pragma unroll
            for (int j = 0; j < 4; ++j) s += (v[q][j].x * v[q][j].x + v[q][j].y * v[q][j].y) + (v[q][j].z * v[q][j].z + v[q][j].w * v[q][j].w);
            const float rs = __builtin_amdgcn_rsqf(wave_sum(s) * (1.f / D) + EPS);
            f32x4* xo = (f32x4*)(X + (size_t)mr[q] * D) + lane;
            if (ok[q]) {
#pragma unroll
                for (int j = 0; j < 4; ++j) __builtin_nontemporal_store(v[q][j] * rs * ggv[j], xo + 64 * j); }
        }
    }
}
__device__ __forceinline__ void moe_prep_weights(const Args& A, LAS unsigned char* lds, int gw, int ngw, int wave, int lane) {
    unsigned char* ws = A.ws; LAS float* scr = (LAS float*)(lds + wave * 16384);
    for (int e = 0; e < NEXP; ++e) {
        const float* wg = INF(I_MOE_WG) + (size_t)e * D * DFF; const float* wu = INF(I_MOE_WU) + (size_t)e * D * DFF;
        transpose_matrix8(SrcMap{wg, (long long)(wu - wg), 2, DFF}, DFF, D, 2 * DFF, ws + WS_MWGU + (size_t)e * 2 * DFF * D, F8_WGU, scr, gw, ngw, lane);
        transpose_matrix8(SrcMap{INF(I_MOE_WD) + (size_t)e * DFF * D, 0, 0, D}, D, DFF, D, ws + WS_MWD + (size_t)e * D * DFF, F8_WD, scr, gw, ngw, lane, 1);
    }
}

#ifndef MK_MULTI
#define MK_MULTI 0
#endif
#ifndef HAVE_MOE
#define HAVE_MOE 1
#endif
#ifndef DUP_PREP
#define DUP_PREP 1
#endif
#ifndef DUP_ATTN
#define DUP_ATTN 1
#endif
#ifndef DUP_MLA
#define DUP_MLA 1
#endif
#ifndef DUP_NSA
#define DUP_NSA 1
#endif
#ifndef DUP_GEMM
#define DUP_GEMM 1
#endif
#ifndef DUP_P0
#define DUP_P0 1
#endif
#ifndef DUP_MOEW
#define DUP_MOEW 1
#endif
#ifndef DUP_NORM
#define DUP_NORM 1
#endif
#ifndef DUP_FIN
#define DUP_FIN 1
#endif
#ifndef FFN_CH
#define FFN_CH 0
#endif
#ifndef ALIGN_GU
#define ALIGN_GU true
#endif
#ifndef SP2_GU
#define SP2_GU true
#endif
constexpr int FO = FFN_CH ? 2 : 0;
constexpr int N_PHASES = (HAVE_MOE ? 22 : 16) + FO;

#define IN(k) (lo <= (k) && (k) < hi)
#define SEAM(k) do { if ((k) + 1 < hi) xcd_barrier(bar); } while (0)
template <int L> __device__ __forceinline__ void mixer_phases(const Args& A, LAS unsigned char* lds, const XcdBarrier& bar, int lo, int hi, int G) {
    unsigned char* ws = A.ws; (void)ws;
        constexpr int pb = 1 + (9 + FO) * L;
        if (IN(pb + 0)) { constexpr int ll = L;
#if INPROJ_F8
            pg8::Gemm g{(const pg8::bf16_t*)(ws + WS_HN), (const pg8::bf16_t*)(ws + WS_WIN + (size_t)ll * INC * D), T, INC, D / 2, 0};
            pg8::StaticOrder S; S.init(T, INC, G, (int)blockIdx.x);
            pg8::EpiBf16S E{(pg8::bf16_t*)(ws + WS_U), INC, 1.0f / (F8_H * F8_WGU)};
            pg8::gemm_phase<pg8::EpiBf16S, pg8::StaticOrder, true, true, true>(lds, g, S, E);
#elif INPROJ_SPLIT
            constexpr int N8 = 256 * INPROJ_SPLIT;
            {   pg8::Gemm g{(const pg8::bf16_t*)(ws + WS_HN8), (const pg8::bf16_t*)(ws + WS_WIN8 + (size_t)ll * N8 * D), T, N8, D / 2, 0};
                pg8::StaticOrder S; S.init(T, N8, G, (int)blockIdx.x);
                pg8::EpiBf16S E{(pg8::bf16_t*)(ws + WS_U), INC, 1.0f / (F8_H * F8_WGU)};
                pg8::gemm_phase<pg8::EpiBf16S, pg8::StaticOrder, true, true, true>(lds, g, S, E); }
            {   pg8::Gemm g{(const pg8::bf16_t*)(ws + WS_HN), (const pg8::bf16_t*)(ws + WS_WIN) + (size_t)ll * INC * D + (size_t)N8 * D, T, INC - N8, D, 0};
                pg8::StaticOrder S; S.init(T, INC - N8, G, (int)blockIdx.x);
                pg8::EpiBf16<0> E{(pg8::bf16_t*)(ws + WS_U) + N8, INC, nullptr, 0, 0, 1.f};
                pg8::gemm_phase<pg8::EpiBf16<0>, pg8::StaticOrder, true, true>(lds, g, S, E); }
#else
            pg8::Gemm g{(const pg8::bf16_t*)(ws + WS_HN), (const pg8::bf16_t*)(ws + WS_WIN) + (size_t)ll * INC * D, T, INC, D, 0};
            pg8::StaticOrder S; S.init(T, INC, G, (int)blockIdx.x);
            pg8::EpiBf16<0> E{(pg8::bf16_t*)(ws + WS_U), INC, nullptr, 0, 0, 1.f};
            pg8::gemm_phase<pg8::EpiBf16<0>, pg8::StaticOrder, true, true>(lds, g, S, E);
#endif
            SEAM(pb + 0);
        }
        if (IN(pb + 1)) { constexpr int ll = L;
            if (threadIdx.x < KM_WORDS) ((LAS unsigned*)(lds + LDS_MISC + 64))[threadIdx.x] = 0u;
            __syncthreads();
            for (int rep = 0; rep < DUP_PREP; ++rep) {
#ifndef RP_LRU
#define RP_LRU 1
#endif
#ifndef RP_MLA
#define RP_MLA 1
#endif
#ifndef RP_NSA
#define RP_NSA 1
#endif
#ifndef RP_SSD
#define RP_SSD 1
#endif
            for (int tile = blockIdx.x; tile < T / 64; tile += G) { for (int r_ = 0; r_ < RP_LRU; ++r_) lru_local_tile(A, ll, tile, lds); for (int r_ = 0; r_ < RP_MLA; ++r_) mla_prep_tile(A, ll, tile, lds); for (int r_ = 0; r_ < RP_NSA; ++r_) nsa_prep_tile(A, ll, tile, lds); }
            for (int r_ = 0; r_ < RP_SSD; ++r_) for (int u = blockIdx.x; u < NB * 64 * 2; u += G) ssd_state_unit(A, ll, u, lds); }
            __syncthreads();
            if (threadIdx.x < KM_WORDS) ((unsigned*)(ws + WS_CTL) + CW_KMG)[(size_t)(ll * KM_WORDS + threadIdx.x) * 256 + (blockIdx.x & 255)] = ((LAS unsigned*)(lds + LDS_MISC + 64))[threadIdx.x];
            SEAM(pb + 1);
        }
        if (IN(pb + 2)) { constexpr int ll = L;
            unsigned* qctr = (unsigned*)(ws + WS_CTL) + CW_Q + 128 * L; volatile LAS unsigned* slot = (volatile LAS unsigned*)(lds + LDS_MISC) + 4;
#ifndef REP_MLA
#define REP_MLA 1
#endif
#ifndef STATIC_ATTN
#define STATIC_ATTN 0
#endif
            int steal = 0;
            for (int it_ = 0;; ++it_) {
                __syncthreads();
                if (threadIdx.x == 0) { unsigned code = ~0u;
                    while (steal < (STATIC_ATTN ? 1 : 8)) { const int g = (int)((blockIdx.x + steal) & 7), nw = (G - g + 7) >> 3;
                        const unsigned pos = STATIC_ATTN ? (unsigned)((blockIdx.x >> 3) + it_ * nw) : (it_ == 0 && steal == 0 ? (unsigned)(blockIdx.x >> 3) : atomicAdd(qctr + 16 * g, 1u) + (unsigned)nw);
                        if (pos < 137u) { code = (unsigned)g * 256u + pos; break; }
                        ++steal; }
                    *slot = code; }
                __syncthreads();
                const unsigned code = *slot;
                if (code == ~0u) break;
                const int g = (int)(code >> 8), pos = (int)(code & 255);
                if (pos < 32 || (pos >= 41 && pos < 73)) { const int j = pos < 32 ? pos : pos - 9; for (int r_ = 0; r_ < REP_MLA; ++r_) mla_attn_unit(A, ll, g + 8 * (j & 1), 31 - (j >> 1), lds); }
                else if (pos < 40) ssd_prop_unit(A, (pos - 32) * 8 + g);
                else if (pos == 40) { if (g < 4) lru_carry_unit(A, g); }
                else { const int k = pos - 73; nsa_unit(A, ll, (g & 3) * 128 + 127 - (2 * k + (g >> 2)), lds); }
            }
            SEAM(pb + 2);
        }
        if (IN(pb + 3)) { constexpr int ll = L;
            for (int rep = 0; rep < DUP_FIN; ++rep) {
#ifndef RF_LRU
#define RF_LRU 1
#endif
#ifndef RF_GN
#define RF_GN 1
#endif
#ifndef RF_SSD
#define RF_SSD 1
#endif
            for (int tile = blockIdx.x; tile < T / 64; tile += G) { for (int r_ = 0; r_ < RF_LRU; ++r_) lru_final_tile(A, ll, tile); for (int r_ = 0; r_ < RF_GN; ++r_) group_norm_tile(A, ll, tile, 0); }
            for (int r_ = 0; r_ < RF_SSD; ++r_) for (int u = blockIdx.x; u < NB * 64; u += G) ssd_final_unit(A, ll, u, lds); }
            SEAM(pb + 3);
        }
        if (IN(pb + 4)) { constexpr int ll = L;
            pg8::Gemm g{(const pg8::bf16_t*)(ws + WS_Y), (const pg8::bf16_t*)(ws + WS_WOUT) + (size_t)ll * D * D, T, D, D, 0};
            pg8::StaticOrder S; S.init(T, D, G, (int)blockIdx.x);
            pg8::EpiResF32 E{ll == 0 ? INF(I_X) : (const float*)A.out, A.out, D, 1.0f};
            pg8::gemm_phase<pg8::EpiResF32, pg8::StaticOrder, true, true>(lds, g, S, E);
            SEAM(pb + 4);
        }
}
__global__ void __launch_bounds__(NTHR, 2) fwd_kernel(Args A) {
    extern __shared__ __attribute__((aligned(16))) unsigned char lds_raw[];
    LAS unsigned char* lds = (LAS unsigned char*)lds_raw;
    const int tid = threadIdx.x, lane = tid & 63, wave = __builtin_amdgcn_readfirstlane(tid >> 6);
    const int G = gridDim.x, gw = blockIdx.x * NWAVES + wave, ngw = G * NWAVES;
    unsigned char* ws = A.ws;
    volatile LAS unsigned* misc = (volatile LAS unsigned*)(lds + LDS_MISC);
    if (tid < 64) misc[tid] = 0u;
    __syncthreads();
    const int lo = A.ph_lo, hi = A.ph_hi;
    XcdBarrier bar; bar.bar = (unsigned*)(ws + WS_CTL) + CW_BAR; bar.x = 0; bar.st = misc;
    if (hi - lo > 1) bar = xcd_barrier_post((unsigned*)(ws + WS_CTL) + CW_BAR, misc);

    if (IN(0)) {
#if INPROJ_F8
        for (int r2 = 0; r2 < DUP_P0; ++r2) phase_prep_weights(A, lds, gw, ngw, wave, lane);
        phase_norm_rows8(INF(I_X), INF(I_NORM_MIX), ws + WS_HN, F8_H, gw, ngw, lane);
#else
        if ((gw & 1) == 0) { for (int r2 = 0; r2 < DUP_P0; ++r2) phase_prep_weights(A, lds, gw >> 1, ngw >> 1, wave, lane);
            phase_norm_rows(INF(I_X), INF(I_NORM_MIX), (bf16*)(ws + WS_HN), gw >> 1, ngw >> 1, lane, ws + WS_HN8, 0, T / 4); }
        else phase_norm_rows(INF(I_X), INF(I_NORM_MIX), (bf16*)(ws + WS_HN), gw >> 1, ngw >> 1, lane, ws + WS_HN8, T / 4, T);
#endif
        SEAM(0);
#ifdef EXTRA_BARS
        for (int eb_ = 0; eb_ < EXTRA_BARS; ++eb_) xcd_barrier(bar);
#endif
    }
    mixer_phases<0>(A, lds, bar, lo, hi, G);
    {
            if (IN(6)) { phase_norm_rows8(A.out, INF(I_NORM_FFN), ws + WS_HN, F8_H, gw, ngw, lane); SEAM(6); }
#define FFN_CHUNK(c) do { constexpr int RC = FFN_CH ? T / 2 : T;     \
                if (IN(7 + 2 * (c))) { \
                    pg8::Gemm g{(const pg8::bf16_t*)(ws + WS_HN + (size_t)(c) * RC * D), (const pg8::bf16_t*)(ws + WS_FGU), RC, 2 * DFF, D / 2, 0};        \
                    pg8::StaticOrder S; S.init(RC, 2 * DFF, G, (int)blockIdx.x); \
                    pg8::EpiSwiglu8 E{ws + WS_ACT, DFF / 128, 1.0f / (F8_H * F8_WGU), F8_ACT}; \
                    pg8::gemm_phase<pg8::EpiSwiglu8, pg8::StaticOrder, ALIGN_GU, SP2_GU, true>(lds, g, S, E); \
                    SEAM(7 + 2 * (c)); \
                } \
                if (IN(8 + 2 * (c))) { \
                    pg8::Gemm g{(const pg8::bf16_t*)(ws + WS_ACT), (const pg8::bf16_t*)(ws + WS_FD), RC, D, DFF / 2, 0}; \
                    pg8::RowOrder4 S{(RC / 256) * 4, G, (int)blockIdx.x};     \
                    pg8::EpiBf16S E{(pg8::bf16_t*)(ws + WS_DELTA) + (size_t)(c) * RC * D, D, 1.0f / (F8_ACT * F8_WD)};       \
                    pg8::gemm_phase<pg8::EpiBf16S, pg8::RowOrder4, true, true, true, true>(lds, g, S, E); \
                    SEAM(8 + 2 * (c)); \
                } } while (0)
            FFN_CHUNK(0);
#if FFN_CH
            FFN_CHUNK(1);
#endif
#undef FFN_CHUNK
#if INPROJ_F8
            if (IN(9 + FO)) { phase_norm_rows8(A.out, INF(I_NORM_MIX) + D, ws + WS_HN, F8_H, gw, ngw, lane); SEAM(9 + FO); }
#else
            if (IN(9 + FO)) { phase_add_norm_rows(A.out, (const bf16*)(ws + WS_DELTA), INF(I_NORM_MIX) + D, (bf16*)(ws + WS_HN), gw, ngw, lane, ws + WS_HN8); SEAM(9 + FO); }
#endif
    }
    mixer_phases<1>(A, lds, bar, lo, hi, G);
#if HAVE_MOE
    if (IN(15 + FO)) { moe_router_rows(A, lds, gw, ngw, wave, lane); for (int r2 = 0; r2 < DUP_MOEW; ++r2) moe_prep_weights(A, lds, gw, ngw, wave, lane); SEAM(15 + FO); }
    if (IN(16 + FO)) { moe_permute_rows(A, gw, ngw, lane); SEAM(16 + FO); }
    for (int c = 0; c < 2; ++c) {
        if (IN(17 + FO + 2 * c)) {
            const int* te = (const int*)(ws + WS_TILEE); const int ntile = te[511]; int nt = c == 0 ? (ntile < 128 ? ntile : 128) : (ntile > 128 ? ntile - 128 : 0);
            pg8::Gemm g{(const pg8::bf16_t*)(ws + WS_HPERM + (size_t)c * 32768 * D), (const pg8::bf16_t*)(ws + WS_MWGU), nt * 256, 2 * DFF, D / 2, 0};
            pg8::MoeOrder S; S.init(nt * 256, 2 * DFF, G, (int)blockIdx.x); S.tile_e = te; S.tile0 = 128 * c; S.estride = (size_t)2 * DFF * D;
            pg8::EpiSwiglu8 E{ws + WS_MACT, DFF / 128, 1.0f / (F8_H * F8_WGU), F8_ACT};
            pg8::gemm_phase<pg8::EpiSwiglu8, pg8::MoeOrder, ALIGN_GU, SP2_GU, true>(lds, g, S, E);
            SEAM(17 + FO + 2 * c);
        }
        if (IN(18 + FO + 2 * c)) {
            const int* te = (const int*)(ws + WS_TILEE); const int ntile = te[511]; int nt = c == 0 ? (ntile < 128 ? ntile : 128) : (ntile > 128 ? ntile - 128 : 0); const int ntl = nt > 128 ? nt - 128 : 0; nt -= ntl;
            pg8::EpiMoeDown E{(const int*)(ws + WS_ROWTOK), (const float*)(ws + WS_ROWW), (pg8::bf16_t*)(ws + WS_PARKB), (pg8::bf16_t*)(ws + WS_Y1), c * 32768, 1.0f / (F8_ACT * F8_WD)};
            {   pg8::Gemm g{(const pg8::bf16_t*)(ws + WS_MACT), (const pg8::bf16_t*)(ws + WS_MWD), nt * 256, D, DFF / 2, 0};
                pg8::MoeOrder S; S.init(nt * 256, D, G, (int)blockIdx.x); S.tile_e = te; S.tile0 = 128 * c; S.estride = (size_t)D * DFF;
                pg8::gemm_phase<pg8::EpiMoeDown, pg8::MoeOrder, true, true, true, true>(lds, g, S, E); }
            if (c == 1 && ntl > 0) {
                pg8::Gemm g{(const pg8::bf16_t*)(ws + WS_MACT) + (size_t)128 * 256 * (DFF / 2), (const pg8::bf16_t*)(ws + WS_MWD), ntl * 256, D, DFF / 4, DFF / 128};
                pg8::TailOrder S{te, 256, ntl, G, (int)blockIdx.x, (size_t)D * DFF};
                pg8::EpiMoeDown E2 = E; E2.row0g = 65536;
                pg8::gemm_phase<pg8::EpiMoeDown, pg8::TailOrder, true, true, true, true>(lds, g, S, E2); }
            SEAM(18 + FO + 2 * c);
        }
    }
    if (IN(21 + FO)) phase_final_norm_moe(A, gw, ngw, lane);
#else
    if (IN(15)) phase_final_norm(A.out, INF(I_NORM_FINAL), gw, ngw, lane);
#endif
#undef IN
#undef SEAM
}

extern "C" void kernel_launch(void* const* d_in, const int* in_sizes, int n_in, void* d_out, int out_size, void* d_ws, size_t ws_size, hipStream_t stream) {
    static int grid = 0;
    if (grid == 0) {
        if (n_in != N_IN || in_sizes[0] != T * D || out_size != T * D || ws_size < WS_END) {
            fprintf(stderr, "kernel_launch: unexpected problem (n_in %d, in0 %d, out %d, ws %zu); nothing launched\n", n_in, n_in > 0 ? in_sizes[0] : -1, out_size, ws_size); grid = -1; return; }
        int dev = 0, cus = 0, per_cu = 0;
        if (hipGetDevice(&dev) != hipSuccess || hipDeviceGetAttribute(&cus, hipDeviceAttributeMultiprocessorCount, dev) != hipSuccess) { grid = -1; return; }
        if (hipFuncSetAttribute((const void*)fwd_kernel, hipFuncAttributeMaxDynamicSharedMemorySize, LDS_BYTES) != hipSuccess) { fprintf(stderr, "kernel_launch: hipFuncSetAttribute failed\n"); grid = -1; return; }
        if (hipOccupancyMaxActiveBlocksPerMultiprocessor(&per_cu, (const void*)fwd_kernel, NTHR, LDS_BYTES) != hipSuccess || per_cu < 1)
            fprintf(stderr, "kernel_launch: note: occupancy query reports %d workgroups per CU\n", per_cu);
        (void)hipGetLastError();
        grid = cus;
    }
    if (grid < 0) return;
    if (hipMemsetAsync((char*)d_ws + WS_CTL, 0, CTL_BYTES, stream) != hipSuccess) return;
    Args a{};
    for (int i = 0; i < N_IN; ++i) a.in[i] = d_in[i];
    a.out = (float*)d_out; a.ws = (unsigned char*)d_ws;
#if MK_MULTI
#ifndef DUPMASK
#define DUPMASK 0u
#endif
    for (int p = 0; p < N_PHASES; ++p) { a.ph_lo = p; a.ph_hi = p + 1; for (int r = 0; r < (((DUPMASK) >> p) & 1u ? 2 : 1); ++r) hipLaunchKernelGGL(fwd_kernel, dim3(grid), dim3(NTHR), LDS_BYTES, stream, a); }
#else
    a.ph_lo = 0; a.ph_hi = N_PHASES;
    hipLaunchKernelGGL(fwd_kernel, dim3(grid), dim3(NTHR), LDS_BYTES, stream, a);
#endif
}
```
